# Optimizing an MI355X kernel written in HIP

```python
import jax, jax.numpy as jnp
from jax import lax
import numpy as np

D_MODEL = 1024
BATCH = 8
SEQ = 2048
DEPTH = 2

GRID_W = 64
CTX_LEN = 256
N_HEADS = 8
HEAD_DIM = 64
ATTN_W = N_HEADS * HEAD_DIM
CONV_W = 512
CONV_K = 3
NA_ROWS = 8
NA_COLS = 16
D_FF = 2816
N_EXPERTS = 8
TOP_K = 2
N_DENSE = (DEPTH + 1) // 2
N_MOE = DEPTH // 2
PROJ_W = 3 * ATTN_W + 3 * CONV_W
EPS = 1e-6
NEG_INF = -1e30

kernel_name = "hybrid_natten_shortconv_moe_dit_block"


def rmsnorm(x, g):
    xf = x.astype(jnp.float32)
    y = xf * lax.rsqrt(jnp.mean(xf * xf, axis=-1, keepdims=True) + EPS)
    return y.astype(x.dtype) * g


def modulate(x, g, shift, scale):
    return rmsnorm(x, g) * (1 + scale) + shift


def heads(t):
    return t.reshape(*t.shape[:-1], N_HEADS, HEAD_DIM)


def split_proj(p):
    a, cw = ATTN_W, CONV_W
    q = p[..., :a]
    k = p[..., a:2 * a]
    v = p[..., 2 * a:3 * a]
    bg = p[..., 3 * a:3 * a + cw]
    cg = p[..., 3 * a + cw:3 * a + 2 * cw]
    u = p[..., 3 * a + 2 * cw:]
    return q, k, v, bg, cg, u


def neighbourhood_attention(q, k, v, k_ctx, v_ctx, rpb):
    b, s, h, dh = q.shape
    rows = s // GRID_W
    kh = min(NA_ROWS, rows)
    scale = dh ** -0.5
    q = q.reshape(b, rows, GRID_W, h, dh)
    k = k.reshape(b, rows, GRID_W, h, dh)
    v = v.reshape(b, rows, GRID_W, h, dh)
    r = jnp.arange(rows)
    row_start = jnp.clip(r - kh // 2, 0, rows - kh)
    key_rows = row_start[:, None] + jnp.arange(kh)[None, :]
    k_rows = k[:, key_rows]
    v_rows = v[:, key_rows]
    col = jnp.arange(GRID_W)
    col_start = jnp.clip(col - NA_COLS // 2, 0, GRID_W - NA_COLS)
    in_win = (col[None, :] >= col_start[:, None]) & (col[None, :] < col_start[:, None] + NA_COLS)
    dr = key_rows - r[:, None]
    dc = jnp.clip(col[None, :] - col[:, None], -(NA_COLS - 1), NA_COLS - 1)
    bias = rpb[:, (dr + NA_ROWS - 1)[:, None, :, None], (dc + NA_COLS - 1)[None, :, None, :]]
    s_loc = jnp.einsum('brchd,briwhd->bhrciw', q, k_rows).astype(jnp.float32) * scale + bias[None].astype(jnp.float32)
    s_loc = jnp.where(in_win[:, None, :], s_loc, NEG_INF)
    s_ctx = jnp.einsum('brchd,blhd->bhrcl', q, k_ctx).astype(jnp.float32) * scale
    n_loc = kh * GRID_W
    p = jax.nn.softmax(jnp.concatenate([s_loc.reshape(b, h, rows, GRID_W, n_loc), s_ctx], axis=-1), axis=-1).astype(v.dtype)
    p_loc = p[..., :n_loc].reshape(b, h, rows, GRID_W, kh, GRID_W)
    p_ctx = p[..., n_loc:]
    o = jnp.einsum('bhrciw,briwhd->brchd', p_loc, v_rows) + jnp.einsum('bhrcl,blhd->brchd', p_ctx, v_ctx)
    return o.reshape(b, s, h * dh)


def context_attention(q, k, v):
    b, l, h, dh = q.shape
    s = jnp.einsum('blhd,bmhd->bhlm', q, k).astype(jnp.float32) * (dh ** -0.5)
    p = jax.nn.softmax(s, axis=-1).astype(v.dtype)
    return jnp.einsum('bhlm,bmhd->blhd', p, v).reshape(b, l, h * dh)


def short_conv(u, bg, cg, w_conv):
    s = u.shape[1]
    z = jnp.pad(cg * u, ((0, 0), (CONV_K // 2, CONV_K // 2), (0, 0)))
    y = z[:, 0:s] * w_conv[0]
    for tap in range(1, CONV_K):
        y = y + z[:, tap:tap + s] * w_conv[tap]
    return bg * y


def merge_branches(h, y_attn, y_conv, w_attn_out, w_conv_out, w_gate, b_gate, w_out):
    gates = jax.nn.sigmoid(h @ w_gate + b_gate)
    merged = gates[..., :D_MODEL] * (y_attn @ w_attn_out) + gates[..., D_MODEL:] * (y_conv @ w_conv_out)
    return merged @ w_out


def swiglu(h, wg, wu, wd):
    return (jax.nn.silu(h @ wg) * (h @ wu)) @ wd


def moe_swiglu(h, w_router, w_exp_gate, w_exp_up, w_exp_down):
    logits = (h @ w_router).astype(jnp.float32)
    top_val, top_idx = lax.top_k(logits, TOP_K)
    top_p = jax.nn.softmax(top_val, axis=-1)
    combine = jnp.einsum('...k,...ke->...e', top_p, jax.nn.one_hot(top_idx, N_EXPERTS, dtype=jnp.float32)).astype(h.dtype)
    y = combine[..., 0:1] * swiglu(h, w_exp_gate[0], w_exp_up[0], w_exp_down[0])
    for e in range(1, N_EXPERTS):
        y = y + combine[..., e:e + 1] * swiglu(h, w_exp_gate[e], w_exp_up[e], w_exp_down[e])
    return y


def setup_inputs(seed: int = 0) -> dict:
    key = jax.random.key(seed)
    ks = jax.random.split(key, 26)
    f32 = jnp.float32
    D = D_MODEL

    def nrm(k, shape, scale):
        return jax.random.normal(k, shape, f32) * scale

    return {
        "x": nrm(ks[0], (BATCH, SEQ, D), 1.0),
        "c": nrm(ks[1], (BATCH, D), 1.0),
        "ctx": nrm(ks[2], (BATCH, CTX_LEN, D), 1.0),
        "c_ctx": nrm(ks[3], (D,), 1.0),
        "w_ada": nrm(ks[4], (DEPTH, D, 6 * D), 0.5 * D ** -0.5),
        "b_ada": nrm(ks[5], (DEPTH, 6 * D), 0.02),
        "norm_mix": 1.0 + nrm(ks[6], (DEPTH, D), 0.02),
        "norm_ffn": 1.0 + nrm(ks[7], (DEPTH, D), 0.02),
        "w_in": nrm(ks[8], (DEPTH, D, PROJ_W), D ** -0.5),
        "w_conv": nrm(ks[9], (DEPTH, CONV_K, CONV_W), CONV_K ** -0.5),
        "rpb": nrm(ks[10], (DEPTH, N_HEADS, 2 * NA_ROWS - 1, 2 * NA_COLS - 1), 0.2),
        "w_attn_out": nrm(ks[11], (DEPTH, ATTN_W, D), ATTN_W ** -0.5),
        "w_conv_out": nrm(ks[12], (DEPTH, CONV_W, D), CONV_W ** -0.5),
        "w_gate": nrm(ks[13], (DEPTH, D, 2 * D), D ** -0.5),
        "b_gate": nrm(ks[14], (DEPTH, 2 * D), 0.02),
        "w_out": nrm(ks[15], (DEPTH, D, D), D ** -0.5),
        "w_ffn_gate": nrm(ks[16], (N_DENSE, D, D_FF), D ** -0.5),
        "w_ffn_up": nrm(ks[17], (N_DENSE, D, D_FF), D ** -0.5),
        "w_ffn_down": nrm(ks[18], (N_DENSE, D_FF, D), D_FF ** -0.5),
        "w_router": nrm(ks[19], (N_MOE, D, N_EXPERTS), D ** -0.5),
        "w_exp_gate": nrm(ks[20], (N_MOE, N_EXPERTS, D, D_FF), D ** -0.5),
        "w_exp_up": nrm(ks[21], (N_MOE, N_EXPERTS, D, D_FF), D ** -0.5),
        "w_exp_down": nrm(ks[22], (N_MOE, N_EXPERTS, D_FF, D), D_FF ** -0.5),
        "norm_final": 1.0 + nrm(ks[23], (D,), 0.02),
    }


def reference(x, c, ctx, c_ctx, w_ada, b_ada, norm_mix, norm_ffn, w_in, w_conv, rpb,
              w_attn_out, w_conv_out, w_gate, b_gate, w_out, w_ffn_gate, w_ffn_up, w_ffn_down,
              w_router, w_exp_gate, w_exp_up, w_exp_down, norm_final):
    s_lat = x.shape[1]
    cond_lat = jax.nn.silu(c)
    cond_ctx = jax.nn.silu(c_ctx)
    for l in range(DEPTH):
        last = l == DEPTH - 1
        mod_lat = (cond_lat @ w_ada[l] + b_ada[l])[:, None, :]
        mod_ctx = cond_ctx @ w_ada[l] + b_ada[l]
        sh1, sc1, g1, sh2, sc2, g2 = jnp.split(mod_lat, 6, axis=-1)
        sh1c, sc1c, g1c, sh2c, sc2c, g2c = jnp.split(mod_ctx, 6, axis=-1)

        h = modulate(x, norm_mix[l], sh1, sc1)
        hc = modulate(ctx, norm_mix[l], sh1c, sc1c)
        q, k, v, bg, cg, u = split_proj(h @ w_in[l])
        if last:
            kv_c = hc @ w_in[l][:, ATTN_W:3 * ATTN_W]
            k_c, v_c = kv_c[..., :ATTN_W], kv_c[..., ATTN_W:]
        else:
            q_c, k_c, v_c, bg_c, cg_c, u_c = split_proj(hc @ w_in[l])
        y_attn = neighbourhood_attention(heads(q), heads(k), heads(v), heads(k_c), heads(v_c), rpb[l])
        y_conv = short_conv(u, bg, cg, w_conv[l])
        x = x + g1 * merge_branches(h, y_attn, y_conv, w_attn_out[l], w_conv_out[l], w_gate[l], b_gate[l], w_out[l])
        if not last:
            yc_attn = context_attention(heads(q_c), heads(k_c), heads(v_c))
            yc_conv = short_conv(u_c, bg_c, cg_c, w_conv[l])
            ctx = ctx + g1c * merge_branches(hc, yc_attn, yc_conv, w_attn_out[l], w_conv_out[l], w_gate[l], b_gate[l], w_out[l])

        h = modulate(x, norm_ffn[l], sh2, sc2)
        if not last:
            h = jnp.concatenate([h, modulate(ctx, norm_ffn[l], sh2c, sc2c)], axis=1)
        if l % 2 == 0:
            y = swiglu(h, w_ffn_gate[l // 2], w_ffn_up[l // 2], w_ffn_down[l // 2])
        else:
            y = moe_swiglu(h, w_router[l // 2], w_exp_gate[l // 2], w_exp_up[l // 2], w_exp_down[l // 2])
        x = x + g2 * y[:, :s_lat]
        if not last:
            ctx = ctx + g2c * y[:, s_lat:]
    return rmsnorm(x, norm_final)
```

```cpp
#include <hip/hip_runtime.h>
#include <cstdio>
#include <cstdint>
#ifndef MK_N_LAUNCHES
#define MK_N_LAUNCHES 1
#endif
namespace pg8 {
#define PG8_LAS __attribute__((address_space(3)))
typedef unsigned short bf16_t;
typedef short bf16x8 __attribute__((ext_vector_type(8)));
typedef float f32x4 __attribute__((ext_vector_type(4)));
typedef unsigned u32x4 __attribute__((ext_vector_type(4)));
typedef int i32x4 __attribute__((ext_vector_type(4)));
typedef int i32x8 __attribute__((ext_vector_type(8)));
constexpr int BM = 256, BK = 64, HALF = 128, HTB = HALF * BK * 2  , STAGE_BYTES = 8 * HTB, NXCD = 8, WGM = 8;

__host__ __device__ __forceinline__ int lds_byte(int r, int c) { const int st = (r >> 4) * 2 + (c >> 5), rr = r & 15, cc = c & 31, ob = rr * 64 + cc * 2; return st * 1024 + (ob ^ (((ob >> 9) & 1) << 5)); }
__host__ __device__ __forceinline__ void stage_rc(int b, int& R, int& C) { const int st = b / 1024, sb = b % 1024, swz = sb ^ (((sb >> 9) & 1) << 5); R = (st >> 1) * 16 + swz / 64; C = (st & 1) * 32 + (swz % 64) / 2; }
__host__ __device__ __forceinline__ int perm32(int rho) { const int n = rho >> 4, i = rho & 15; return 8 * (i >> 2) + 4 * n + (i & 3); }

struct Unit { int pm, pn, pc; };
struct Gemm { const bf16_t* A; const bf16_t* Bt; int M, N, K; size_t kstepB; };

struct StaticOrder {
    int nM, nN, nwg, G, c;
    __host__ __device__ void init(int M, int N, int G_, int c_) { nM = M / BM; nN = N / BM; nwg = nM * nN; G = G_; c = c_; }
    __host__ __device__ bool next(int i, Unit& u) const {
        const long L = (long)i * G + c; if (L >= nwg) return false;
        int wgid = (int)L; { const int q = nwg / NXCD, r = nwg % NXCD, xcd = wgid % NXCD, off = wgid / NXCD; wgid = (xcd < r ? xcd * (q + 1) : r * (q + 1) + (xcd - r) * q) + off; }
        const int nig = WGM * nN, gid = wgid / nig, fm = gid * WGM, gsz = (nM - fm) < WGM ? (nM - fm) : WGM;
        u.pm = fm + ((wgid % nig) % gsz); u.pn = (wgid % nig) / gsz; u.pc = u.pn; return true;
    }
    __device__ __forceinline__ void a_ready(const Unit&) const {}
    __device__ __forceinline__ void done(const Unit&) const {}
};


typedef float f32x2_t __attribute__((ext_vector_type(2))); typedef __bf16 bf16x2_t __attribute__((ext_vector_type(2)));
__device__ __forceinline__ unsigned cvt_pk_bf16(float lo, float hi) { f32x2_t v = {lo, hi}; bf16x2_t b = __builtin_convertvector(v, bf16x2_t); return __builtin_bit_cast(unsigned, b); }
__device__ __forceinline__ float bf_lo(unsigned w) { return __builtin_bit_cast(float, w << 16); }
__device__ __forceinline__ float bf_hi(unsigned w) { return __builtin_bit_cast(float, w & 0xffff0000u); }
__device__ __forceinline__ float fast_sigmoid(float x) { return __builtin_amdgcn_rcpf(1.0f + __builtin_amdgcn_exp2f(-1.4426950408889634f * x)); }

struct EpiProj {
    static constexpr bool PERM = true, AFTER_DRAIN = false;
    bf16_t* P1; bf16_t* GT; const float* bgate; float qscale; float dsc;
    __device__ __forceinline__ void operator()(const f32x4 (&acc)[2][2][4][2], const Unit& u, int wr, int wc, int fr, int fq) const {
        const int row0 = u.pm * BM + wr * 64 + fr, cin = wc * 32 + 8 * fq;
        if (u.pc < 12) {
            const float sc = (u.pc < 2) ? qscale * dsc : dsc;
#pragma unroll
            for (int ai = 0; ai < 2; ++ai)
#pragma unroll
                for (int m = 0; m < 4; ++m) { bf16_t* rowp = P1 + (size_t)(row0 + ai * HALF + m * 16) * 3072 + u.pc * BM + cin;
#pragma unroll
                    for (int bj = 0; bj < 2; ++bj) { const f32x4 v0 = acc[ai][bj][m][0] * sc, v1 = acc[ai][bj][m][1] * sc;
                        u32x4 w; w.x = cvt_pk_bf16(v0[0], v0[1]); w.y = cvt_pk_bf16(v0[2], v0[3]); w.z = cvt_pk_bf16(v1[0], v1[1]); w.w = cvt_pk_bf16(v1[2], v1[3]);
                        *(u32x4*)(rowp + bj * HALF) = w; } }
        } else {
            const int gcol = (u.pc - 12) * BM + cin;
            f32x4 bv[2][2];
#pragma unroll
            for (int bj = 0; bj < 2; ++bj)
#pragma unroll
                for (int n = 0; n < 2; ++n) bv[bj][n] = *(const f32x4*)(bgate + gcol + bj * HALF + 4 * n);
#pragma unroll
            for (int ai = 0; ai < 2; ++ai)
#pragma unroll
                for (int m = 0; m < 4; ++m) { bf16_t* rowp = GT + (size_t)(row0 + ai * HALF + m * 16) * 2048 + gcol;
#pragma unroll
                    for (int bj = 0; bj < 2; ++bj) { const f32x4 v0 = acc[ai][bj][m][0] * dsc + bv[bj][0], v1 = acc[ai][bj][m][1] * dsc + bv[bj][1];
                        u32x4 w; w.x = cvt_pk_bf16(fast_sigmoid(v0[0]), fast_sigmoid(v0[1])); w.y = cvt_pk_bf16(fast_sigmoid(v0[2]), fast_sigmoid(v0[3]));
                        w.z = cvt_pk_bf16(fast_sigmoid(v1[0]), fast_sigmoid(v1[1])); w.w = cvt_pk_bf16(fast_sigmoid(v1[2]), fast_sigmoid(v1[3]));
                        *(u32x4*)(rowp + bj * HALF) = w; } }
        }
    }
};

template <bool SECOND> struct EpiMerge {
    static constexpr bool PERM = true, AFTER_DRAIN = false;
    bf16_t* MG; const bf16_t* GT; int gofs;
    __device__ __forceinline__ void operator()(const f32x4 (&acc)[2][2][4][2], const Unit& u, int wr, int wc, int fr, int fq) const {
        const int row0 = u.pm * BM + wr * 64 + fr, col0 = u.pc * BM + wc * 32 + 8 * fq;
#pragma unroll
        for (int ai = 0; ai < 2; ++ai)
#pragma unroll
            for (int m = 0; m < 4; ++m) { const size_t row = (size_t)(row0 + ai * HALF + m * 16);
#pragma unroll
                for (int bj = 0; bj < 2; ++bj) {
                    const u32x4 g = *(const u32x4*)(GT + row * 2048 + gofs + col0 + bj * HALF);
                    const f32x4 a0 = acc[ai][bj][m][0], a1 = acc[ai][bj][m][1];
                    float o[8] = {bf_lo(g.x) * a0[0], bf_hi(g.x) * a0[1], bf_lo(g.y) * a0[2], bf_hi(g.y) * a0[3], bf_lo(g.z) * a1[0], bf_hi(g.z) * a1[1], bf_lo(g.w) * a1[2], bf_hi(g.w) * a1[3]};
                    bf16_t* dst = MG + row * 1024 + col0 + bj * HALF;
                    if (SECOND) { const u32x4 p = *(const u32x4*)dst;
                        o[0] += bf_lo(p.x); o[1] += bf_hi(p.x); o[2] += bf_lo(p.y); o[3] += bf_hi(p.y); o[4] += bf_lo(p.z); o[5] += bf_hi(p.z); o[6] += bf_lo(p.w); o[7] += bf_hi(p.w); }
                    u32x4 w; w.x = cvt_pk_bf16(o[0], o[1]); w.y = cvt_pk_bf16(o[2], o[3]); w.z = cvt_pk_bf16(o[4], o[5]); w.w = cvt_pk_bf16(o[6], o[7]);
                    *(u32x4*)dst = w; } }
    }
};

struct EpiResid {
    static constexpr bool PERM = false, AFTER_DRAIN = false;
    const float* base_lat; const float* base_ctx; float* out; const float* mod;
    __device__ __forceinline__ void operator()(const f32x4 (&acc)[2][2][4][2], const Unit& u, int wr, int wc, int fr, int fq) const {
        const int col0 = u.pc * BM + wc * 32 + 4 * fq;
        const float* gv = mod + (size_t)(u.pm < 64 ? (u.pm >> 3) : 8) * 6144 + col0;
        const float* base = (u.pm < 64 ? base_lat + (size_t)u.pm * BM * 1024 : base_ctx + (size_t)(u.pm - 64) * BM * 1024) + col0;
        float* o = out + (size_t)u.pm * BM * 1024 + col0;
        f32x4 g4[2][2];
#pragma unroll
        for (int bj = 0; bj < 2; ++bj)
#pragma unroll
            for (int n = 0; n < 2; ++n) g4[bj][n] = *(const f32x4*)(gv + bj * HALF + n * 16);
#pragma unroll
        for (int ai = 0; ai < 2; ++ai)
#pragma unroll
            for (int m = 0; m < 4; ++m) { const size_t off = (size_t)(ai * HALF + wr * 64 + m * 16 + fr) * 1024;
#pragma unroll
                for (int bj = 0; bj < 2; ++bj)
#pragma unroll
                    for (int n = 0; n < 2; ++n) { const f32x4 bs = *(const f32x4*)(base + off + bj * HALF + n * 16);
                        *(f32x4*)(o + off + bj * HALF + n * 16) = bs + g4[bj][n] * acc[ai][bj][m][n]; }
                if (m & 1) asm volatile("" ::: "memory"); }
    }
};

struct EpiSwiGLU {
    static constexpr bool PERM = true, AFTER_DRAIN = false;
    bf16_t* HID;
    __device__ __forceinline__ void operator()(const f32x4 (&acc)[2][2][4][2], const Unit& u, int wr, int wc, int fr, int fq) const {
        const int row0 = u.pm * BM + wr * 64 + fr, col0 = u.pc * HALF + wc * 32 + 8 * fq;
#pragma unroll
        for (int ai = 0; ai < 2; ++ai)
#pragma unroll
            for (int m = 0; m < 4; ++m) { float o[8];
#pragma unroll
                for (int n = 0; n < 2; ++n)
#pragma unroll
                    for (int j = 0; j < 4; ++j) { const float gte = acc[ai][0][m][n][j], up = acc[ai][1][m][n][j]; o[4 * n + j] = gte * fast_sigmoid(gte) * up; }
                u32x4 w; w.x = cvt_pk_bf16(o[0], o[1]); w.y = cvt_pk_bf16(o[2], o[3]); w.z = cvt_pk_bf16(o[4], o[5]); w.w = cvt_pk_bf16(o[6], o[7]);
                *(u32x4*)(HID + (size_t)(row0 + ai * HALF + m * 16) * 2816 + col0) = w; }
    }
};

struct EpiYE {
    static constexpr bool PERM = true, AFTER_DRAIN = false;
    bf16_t* YE; float sc;
    __device__ __forceinline__ void operator()(const f32x4 (&acc)[2][2][4][2], const Unit& u, int wr, int wc, int fr, int fq) const {
        const int row0 = u.pm * BM + wr * 64 + fr, col0 = u.pc * BM + wc * 32 + 8 * fq;
#pragma unroll
        for (int ai = 0; ai < 2; ++ai)
#pragma unroll
            for (int m = 0; m < 4; ++m) { bf16_t* rowp = YE + (size_t)(row0 + ai * HALF + m * 16) * 1024 + col0;
#pragma unroll
                for (int bj = 0; bj < 2; ++bj) { const f32x4 v0 = acc[ai][bj][m][0] * sc, v1 = acc[ai][bj][m][1] * sc;
                    u32x4 w; w.x = cvt_pk_bf16(v0[0], v0[1]); w.y = cvt_pk_bf16(v0[2], v0[3]); w.z = cvt_pk_bf16(v1[0], v1[1]); w.w = cvt_pk_bf16(v1[2], v1[3]);
                    *(u32x4*)(rowp + bj * HALF) = w; } }
    }
};
__device__ __forceinline__ float sat448(float v) { return __builtin_fminf(__builtin_fmaxf(v, -448.0f), 448.0f); }
__device__ __forceinline__ unsigned cvt4_fp8(float a, float b, float c, float d) {
    int w = __builtin_amdgcn_cvt_pk_fp8_f32(sat448(a), sat448(b), 0, false); w = __builtin_amdgcn_cvt_pk_fp8_f32(sat448(c), sat448(d), w, true); return (unsigned)w; }
struct EpiSwiGLU8 {
    static constexpr bool PERM = true, AFTER_DRAIN = false;
    unsigned char* HID; float si, so;
    __device__ __forceinline__ void operator()(const f32x4 (&acc)[2][2][4][2], const Unit& u, int wr, int wc, int fr, int fq) const {
        const int row0 = u.pm * BM + wr * 64 + fr, col0 = u.pc * HALF + wc * 32 + 8 * fq;
#pragma unroll
        for (int ai = 0; ai < 2; ++ai)
#pragma unroll
            for (int m = 0; m < 4; ++m) { float o[8];
#pragma unroll
                for (int n = 0; n < 2; ++n)
#pragma unroll
                    for (int j = 0; j < 4; ++j) { const float gte = acc[ai][0][m][n][j] * si, up = acc[ai][1][m][n][j] * si; o[4 * n + j] = gte * fast_sigmoid(gte) * up * so; }
                typedef unsigned u32x2 __attribute__((ext_vector_type(2)));
                u32x2 w; w.x = cvt4_fp8(o[0], o[1], o[2], o[3]); w.y = cvt4_fp8(o[4], o[5], o[6], o[7]);
                *(u32x2*)(HID + (size_t)(row0 + ai * HALF + m * 16) * 2816 + col0) = w; }
    }
};

struct ProjL1Order {
    StaticOrder S0; int G, c;
    __host__ __device__ void init(int G_, int c_) { S0.init(16384, 5120, G_, c_); G = G_; c = c_; }
    __host__ __device__ bool next(int i, Unit& u) const {
        const long L = (long)i * G + c; if (L < S0.nwg) return S0.next(i, u);
        const int r = (int)(L - S0.nwg); if (r >= 32) return false;
        u.pm = 64 + (r & 7); u.pn = 2 + (r >> 3); u.pc = u.pn; return true;
    }
    __device__ __forceinline__ void a_ready(const Unit&) const {}
    __device__ __forceinline__ void done(const Unit&) const {}
};
struct MoEOrder {
    const PG8_LAS int* tab; int NT, G, c;
    __device__ __forceinline__ bool next(int i, Unit& u) const {
        const int L = i * G + c; if (L >= tab[8] * NT) return false;
        int e = 0;
#pragma unroll
        for (int k = 1; k < 8; ++k) e += (L >= tab[k] * NT) ? 1 : 0;
        const int t0 = tab[e], nte = tab[e + 1] - t0, loc = L - t0 * NT;
        const int ct = loc / nte, rt = loc - ct * nte;
        u.pm = t0 + rt; u.pn = e * NT + ct; u.pc = ct; return true;
    }
    __device__ __forceinline__ void a_ready(const Unit&) const {}
    __device__ __forceinline__ void done(const Unit&) const {}
};
template <class Epi, class Sched, bool ALIGN_EPI = false, bool SP2 = false, bool FP8 = false>
__device__ __forceinline__ void gemm_phase(PG8_LAS unsigned char* lds, const Gemm g, const Sched& S, const Epi& E) {
    const int tid = threadIdx.x, wid = __builtin_amdgcn_readfirstlane(tid >> 6), lane = tid & 63, wr = wid >> 2, wc = wid & 3, fr = lane & 15, fq = lane >> 4;
    const int K = g.K, nt = K / BK;
    unsigned voffA[2], voffB[2];
#pragma unroll
    for (int i = 0; i < 2; ++i) { int R, C; stage_rc(tid * 16 + i * 8192, R, C); const int Rb = Epi::PERM ? ((R & ~31) + perm32(R & 31)) : R;
        voffA[i] = (unsigned)(R * K + C) * 2u; voffB[i] = (unsigned)(Rb * BK + C) * 2u; }
    const size_t kstep = (size_t)(BK * 2);
    const size_t hstep = (size_t)HALF * K * 2;
    const size_t tstep = 2 * hstep;
    const size_t kstepB = g.kstepB, hstepB = (size_t)HALF * BK * 2, tstepB = 2 * hstepB;
    const unsigned ldsw = (unsigned)wid * 1024u;
    const int aoff = lds_byte(wr * 64 + fr, fq * 8), boff = lds_byte(wc * 32 + fr, fq * 8);
#define PG8_SA(b, h) (((b) * 2 + (h)) * HTB)
#define PG8_SB(b, h) ((4 + (b) * 2 + (h)) * HTB)
#define PG8_STAGE(bufoff, gbase, voff) do { _Pragma("unroll") for (int _i = 0; _i < 2; ++_i) \
        __builtin_amdgcn_global_load_lds((const unsigned*)((const char*)(gbase) + (voff)[_i]), (PG8_LAS unsigned*)(lds + (bufoff) + ldsw + _i * 8192), 16, 0, 0); } while (0)
#define PG8_LDA(dst, b, h) do { _Pragma("unroll") for (int m = 0; m < 4; ++m) { if constexpr (FP8) { const i32x4 lo_ = *(const PG8_LAS i32x4*)(lds + PG8_SA(b, h) + aoff + m * 2048), hi_ = *(const PG8_LAS i32x4*)(lds + PG8_SA(b, h) + aoff + m * 2048 + 1024); \
        dst##8[m] = __builtin_shufflevector(lo_, hi_, 0, 1, 2, 3, 4, 5, 6, 7); } else { _Pragma("unroll") for (int k = 0; k < 2; ++k) dst[m][k] = *(const PG8_LAS bf16x8*)(lds + PG8_SA(b, h) + aoff + m * 2048 + k * 1024); } } } while (0)
#define PG8_LDB(dst, b, h) do { _Pragma("unroll") for (int n = 0; n < 2; ++n) { if constexpr (FP8) { const i32x4 lo_ = *(const PG8_LAS i32x4*)(lds + PG8_SB(b, h) + boff + n * 2048), hi_ = *(const PG8_LAS i32x4*)(lds + PG8_SB(b, h) + boff + n * 2048 + 1024); \
        dst##8[n] = __builtin_shufflevector(lo_, hi_, 0, 1, 2, 3, 4, 5, 6, 7); } else { _Pragma("unroll") for (int k = 0; k < 2; ++k) dst[n][k] = *(const PG8_LAS bf16x8*)(lds + PG8_SB(b, h) + boff + n * 2048 + k * 1024); } } } while (0)
#define PG8_MMA(ai, bj, At, Bt) do { __builtin_amdgcn_s_setprio(1); _Pragma("unroll") for (int m = 0; m < 4; ++m) _Pragma("unroll") for (int n = 0; n < 2; ++n) { \
        if constexpr (FP8) {   \
            asm volatile("v_mfma_f32_16x16x128_f8f6f4 %0, %1, %2, %0" : "+v"(acc[ai][bj][m][n]) : "v"(Bt##8[n]), "v"(At##8[m]));   \
        } else { _Pragma("unroll") for (int k = 0; k < 2; ++k) acc[ai][bj][m][n] = __builtin_amdgcn_mfma_f32_16x16x32_bf16(Bt[n][k], At[m][k], acc[ai][bj][m][n], 0, 0, 0); } } \
        __builtin_amdgcn_s_setprio(0); } while (0)
#define PG8_WAIT_V(n) asm volatile("s_waitcnt vmcnt(" #n ")" ::: "memory")
#define PG8_WAIT_L(n) asm volatile("s_waitcnt lgkmcnt(" #n ")" ::: "memory")
#define PG8_BAR __builtin_amdgcn_s_barrier()
#define PG8_SCHED __builtin_amdgcn_sched_barrier(0)
    Unit cur, nxt; int ui = 0;
    if (!S.next(0, cur)) return;
    f32x4 acc[2][2][4][2];
#pragma unroll
    for (int a = 0; a < 2; ++a)
#pragma unroll
        for (int b = 0; b < 2; ++b)
#pragma unroll
            for (int m = 0; m < 4; ++m)
#pragma unroll
                for (int n = 0; n < 2; ++n) acc[a][b][m][n] = (f32x4){0.f, 0.f, 0.f, 0.f};
    bf16x8 At[4][2], B0[2][2], B1[2][2]; i32x8 At8[4], B08[2], B18[2];
    const char* cA = (const char*)g.A + (size_t)cur.pm * tstep; const char* cB = (const char*)g.Bt + (size_t)cur.pn * tstepB;
    S.a_ready(cur);
    if constexpr (SP2) {
        PG8_STAGE(PG8_SB(0, 0), cB, voffB); PG8_STAGE(PG8_SB(0, 1), cB + hstepB, voffB); PG8_STAGE(PG8_SA(0, 0), cA, voffA); PG8_STAGE(PG8_SA(0, 1), cA + hstep, voffA);
        if (wr == 1) PG8_BAR;
        PG8_WAIT_V(2); PG8_BAR;
        PG8_STAGE(PG8_SB(1, 0), cB + kstepB, voffB); PG8_STAGE(PG8_SA(1, 0), cA + kstep, voffA); PG8_STAGE(PG8_SB(1, 1), cB + hstepB + kstepB, voffB);
        PG8_WAIT_V(6); PG8_BAR;
    } else {
        PG8_STAGE(PG8_SB(0, 0), cB, voffB); PG8_STAGE(PG8_SA(0, 0), cA, voffA); PG8_STAGE(PG8_SB(0, 1), cB + hstepB, voffB); PG8_STAGE(PG8_SA(0, 1), cA + hstep, voffA);
        if (wr == 1) PG8_BAR;
        PG8_WAIT_V(4); PG8_BAR;
        PG8_STAGE(PG8_SB(1, 0), cB + kstepB, voffB); PG8_STAGE(PG8_SA(1, 0), cA + kstep, voffA); PG8_STAGE(PG8_SB(1, 1), cB + hstepB + kstepB, voffB);
        PG8_WAIT_V(6); PG8_BAR;
    }
    for (;;) {
        const bool has_next = S.next(ui + 1, nxt);
        const char* nA = has_next ? (const char*)g.A + (size_t)nxt.pm * tstep : cA; const char* nB = has_next ? (const char*)g.Bt + (size_t)nxt.pn * tstepB : cB;
        for (int t = 0; t < nt; t += 2) {
            const bool last = (t == nt - 2);
            const char* a1 = cA + (size_t)(t + 1) * kstep;
            const char* a2 = last ? nA : cA + (size_t)(t + 2) * kstep; const char* b2 = last ? nB : cB + (size_t)(t + 2) * kstepB;
            const char* a3 = a2 + kstep; const char* b3 = b2 + kstepB;
            if (last && has_next) S.a_ready(nxt);
            if constexpr (SP2) {
            PG8_LDB(B0, 0, 0); PG8_LDB(B1, 0, 1); PG8_SCHED; PG8_LDA(At, 0, 0); PG8_STAGE(PG8_SA(1, 1), a1 + hstep, voffA);
            PG8_WAIT_V(8); PG8_WAIT_L(0); PG8_BAR; PG8_MMA(0, 0, At, B0); PG8_MMA(0, 1, At, B1); PG8_BAR; PG8_SCHED;
            PG8_LDA(At, 0, 1); PG8_STAGE(PG8_SB(0, 0), b2, voffB); PG8_STAGE(PG8_SB(0, 1), b2 + hstepB, voffB); PG8_STAGE(PG8_SA(0, 0), a2, voffA);
            PG8_WAIT_V(8); PG8_WAIT_L(0); PG8_BAR; PG8_MMA(1, 0, At, B0); PG8_MMA(1, 1, At, B1); PG8_BAR; PG8_SCHED;
            PG8_LDB(B0, 1, 0); PG8_LDB(B1, 1, 1); PG8_SCHED; PG8_LDA(At, 1, 0); PG8_STAGE(PG8_SA(0, 1), a2 + hstep, voffA);
            PG8_WAIT_V(8); PG8_WAIT_L(0); PG8_BAR; PG8_MMA(0, 0, At, B0); PG8_MMA(0, 1, At, B1); PG8_BAR; PG8_SCHED;
            PG8_LDA(At, 1, 1); PG8_STAGE(PG8_SB(1, 0), b3, voffB); PG8_STAGE(PG8_SB(1, 1), b3 + hstepB, voffB); PG8_STAGE(PG8_SA(1, 0), a3, voffA);
            PG8_WAIT_V(8); PG8_WAIT_L(0); PG8_BAR; PG8_MMA(1, 0, At, B0); PG8_MMA(1, 1, At, B1); PG8_BAR; PG8_SCHED;
            } else {
            PG8_LDB(B0, 0, 0); PG8_SCHED; PG8_LDA(At, 0, 0); PG8_STAGE(PG8_SA(1, 1), a1 + hstep, voffA);
            PG8_WAIT_L(8); PG8_BAR; PG8_WAIT_L(0); PG8_MMA(0, 0, At, B0); PG8_BAR; PG8_SCHED;
            PG8_LDB(B1, 0, 1); PG8_STAGE(PG8_SB(0, 0), b2, voffB);
            PG8_BAR; PG8_WAIT_L(0); PG8_MMA(0, 1, At, B1); PG8_BAR;
            PG8_LDA(At, 0, 1); PG8_STAGE(PG8_SA(0, 0), a2, voffA);
            PG8_BAR; PG8_WAIT_L(0); PG8_MMA(1, 0, At, B0); PG8_BAR; PG8_SCHED;
            PG8_STAGE(PG8_SB(0, 1), b2 + hstepB, voffB);
            PG8_WAIT_V(6); PG8_BAR; PG8_MMA(1, 1, At, B1); PG8_BAR;
            PG8_LDB(B0, 1, 0); PG8_SCHED; PG8_LDA(At, 1, 0); PG8_STAGE(PG8_SA(0, 1), a2 + hstep, voffA);
            PG8_WAIT_L(8); PG8_BAR; PG8_WAIT_L(0); PG8_MMA(0, 0, At, B0); PG8_BAR; PG8_SCHED;
            PG8_LDB(B1, 1, 1); PG8_STAGE(PG8_SB(1, 0), b3, voffB);
            PG8_BAR; PG8_WAIT_L(0); PG8_MMA(0, 1, At, B1); PG8_BAR;
            PG8_LDA(At, 1, 1); PG8_STAGE(PG8_SA(1, 0), a3, voffA);
            PG8_BAR; PG8_WAIT_L(0); PG8_MMA(1, 0, At, B0); PG8_BAR; PG8_SCHED;
            PG8_STAGE(PG8_SB(1, 1), b3 + hstepB, voffB);
            PG8_WAIT_V(6); PG8_BAR; PG8_MMA(1, 1, At, B1); PG8_BAR;
            }
        }
        if constexpr (FP8) {
            asm volatile("s_nop 15\n\ts_nop 15\n\ts_nop 7" : "+v"(acc[0][0][0][0]), "+v"(acc[0][0][0][1]), "+v"(acc[0][0][1][0]), "+v"(acc[0][0][1][1]), "+v"(acc[0][0][2][0]), "+v"(acc[0][0][2][1]), "+v"(acc[0][0][3][0]), "+v"(acc[0][0][3][1]));
            asm volatile("" : "+v"(acc[0][1][0][0]), "+v"(acc[0][1][0][1]), "+v"(acc[0][1][1][0]), "+v"(acc[0][1][1][1]), "+v"(acc[0][1][2][0]), "+v"(acc[0][1][2][1]), "+v"(acc[0][1][3][0]), "+v"(acc[0][1][3][1]));
            asm volatile("" : "+v"(acc[1][0][0][0]), "+v"(acc[1][0][0][1]), "+v"(acc[1][0][1][0]), "+v"(acc[1][0][1][1]), "+v"(acc[1][0][2][0]), "+v"(acc[1][0][2][1]), "+v"(acc[1][0][3][0]), "+v"(acc[1][0][3][1]));
            asm volatile("" : "+v"(acc[1][1][0][0]), "+v"(acc[1][1][0][1]), "+v"(acc[1][1][1][0]), "+v"(acc[1][1][1][1]), "+v"(acc[1][1][2][0]), "+v"(acc[1][1][2][1]), "+v"(acc[1][1][3][0]), "+v"(acc[1][1][3][1]));
        }
        if constexpr (ALIGN_EPI) { if (wr == 0) PG8_BAR; }
        if constexpr (!Epi::AFTER_DRAIN) { E(acc, cur, wr, wc, fr, fq); S.done(cur); }
        if (!has_next) break;
#pragma unroll
        for (int a = 0; a < 2; ++a)
#pragma unroll
            for (int b = 0; b < 2; ++b)
#pragma unroll
                for (int m = 0; m < 4; ++m)
#pragma unroll
                    for (int n = 0; n < 2; ++n) acc[a][b][m][n] = (f32x4){0.f, 0.f, 0.f, 0.f};
        cur = nxt; cA = nA; cB = nB; ++ui;
        if constexpr (ALIGN_EPI) { if (wr == 1) PG8_BAR; }
    }
    PG8_WAIT_V(0);
    if constexpr (!ALIGN_EPI) { if (wr == 0) PG8_BAR; }
    PG8_BAR;
    if constexpr (Epi::AFTER_DRAIN) { E.fused(acc, cur, wr, wc, fr, fq, lds, wid, lane); S.done(cur); }
#undef PG8_SA
#undef PG8_SB
#undef PG8_STAGE
#undef PG8_LDA
#undef PG8_LDB
#undef PG8_MMA
#undef PG8_WAIT_V
#undef PG8_WAIT_L
#undef PG8_BAR
#undef PG8_SCHED
}
}

#ifndef PG8_SP2
#define PG8_SP2 true
#endif
#ifndef PG8_ALIGN
#define PG8_ALIGN true
#endif

constexpr int NWAVES = 8;
constexpr int D = 1024, NB = 8, SEQ = 2048, CTXL = 256;
constexpr int TLAT = NB * SEQ, TCTX = NB * CTXL, TALL = TLAT + TCTX;
constexpr int NHEAD = 8, HDIM = 64, AW = 512, CW = 512, PW = 3072, GW = 2048, FF = 2816, NEXP = 8;
constexpr int SLOTS_MAX = 2 * TLAT + NEXP * 256;
constexpr float EPS = 1e-6f, LOG2E = 1.4426950408889634f;
constexpr int NPHASE = 19;
constexpr int N_LAUNCHES = MK_N_LAUNCHES;
static_assert(N_LAUNCHES == 1 || N_LAUNCHES == NPHASE, "MK_N_LAUNCHES is 1 or 19");

constexpr size_t MiB = 1u << 20;
constexpr size_t WS_CTL = 0, CTL_ZERO_BYTES = 1 * MiB;
constexpr size_t WS_MOD = 1 * MiB;
constexpr size_t WS_ROUTE = 2 * MiB;
constexpr size_t WS_X = 4 * MiB;
constexpr size_t WS_RA = 76 * MiB;
constexpr size_t WS_RB = 112 * MiB;
constexpr size_t WS_GT = WS_RB + 108 * MiB;
constexpr size_t WS_YE = WS_RB + 94 * MiB;
constexpr size_t WS_WM0 = 300 * MiB, WS_WM1 = 314 * MiB;
constexpr size_t WS_WD = 328 * MiB;
constexpr size_t WS_WE = 345 * MiB;
constexpr size_t WS_WED = WS_WE + 44 * MiB;
constexpr size_t WS_END = 411 * MiB;
constexpr float S_H2 = 16.f, S_W = 256.f, S_HID = 8.f;
#ifndef PB1_FP8
#define PB1_FP8 0
#endif
constexpr size_t WM_G1 = 0, WM_A = 10 * MiB, WM_C = 11 * MiB, WM_O = 12 * MiB;
constexpr size_t WD_GU = 0, WD_DN = 11 * MiB;
constexpr int CW_BAR = 4096;
constexpr int CW_FILL = 16384;

constexpr int RING_OFF = 0, RING_BYTES = 131072;
constexpr int LDSCTL_OFF = RING_BYTES, MISC_OFF = LDSCTL_OFF + 320;
constexpr int LDS_BYTES = 147456;

#define GAS __attribute__((address_space(1)))
#define LAS __attribute__((address_space(3)))
typedef unsigned short bf16;
typedef unsigned v4u __attribute__((ext_vector_type(4)));
typedef unsigned v2u __attribute__((ext_vector_type(2)));
typedef float f32x4 __attribute__((ext_vector_type(4)));
typedef float f32x16 __attribute__((ext_vector_type(16)));
typedef short bf16x8 __attribute__((ext_vector_type(8)));
typedef short s16x4 __attribute__((ext_vector_type(4)));
typedef GAS unsigned gu32;
#define RLX_AGENT __ATOMIC_RELAXED, __HIP_MEMORY_SCOPE_AGENT
#define LDS_WAIT() asm volatile("s_waitcnt lgkmcnt(0)" ::: "memory")
using pg8::cvt_pk_bf16; using pg8::bf_lo; using pg8::bf_hi;

#define XB_TMO      128
#define XB_XCNT(j)  (256  + 64 * (j))
#define XB_XSUB(j)  (1280 + 64 * (j))
#define XB_XGEN(j)  (2304 + 64 * (j))
#define XB_TOP      3328
#define XB_TOPGEN   3392
#define XCD_BAR_WORDS 3456
#define XB_SPIN_CAP (1u << 18)

__device__ __forceinline__ unsigned xb_ld(unsigned* p)              { return __hip_atomic_load(p, __ATOMIC_RELAXED, __HIP_MEMORY_SCOPE_AGENT); }
__device__ __forceinline__ unsigned xb_add(unsigned* p, unsigned v) { return __hip_atomic_fetch_add(p, v, __ATOMIC_RELAXED, __HIP_MEMORY_SCOPE_AGENT); }
__device__ __forceinline__ unsigned xb_xcc_id() { return (unsigned)__builtin_amdgcn_s_getreg((3 << 11) | 20) & 0xFu; }
#define XB_SPIN(cond, bar) do { unsigned _sp = 0; while (cond) { __builtin_amdgcn_s_sleep(1); \
    if ((++_sp & 255u) == 0u) { if (xb_ld(&(bar)[XB_TMO])) break; if (_sp > XB_SPIN_CAP) { atomicAdd(&(bar)[XB_TMO], 1u); break; } } } } while (0)

struct XcdBarrier {
    unsigned* bar; unsigned x;
    volatile LAS unsigned* st;
};

__device__ __forceinline__ XcdBarrier xcd_barrier_post(unsigned* bar, volatile LAS unsigned* st) {
    XcdBarrier b; b.bar = bar; b.x = xb_xcc_id(); b.st = st;
    if (threadIdx.x == 0) (void)xb_add(&bar[XB_XCNT(b.x)], 1u);
    return b;
}
__device__ __forceinline__ void xcd_barrier_complete(unsigned* bar, unsigned x, unsigned& nloc, unsigned& nx) {
    const unsigned G = gridDim.x * gridDim.y * gridDim.z;
    unsigned sum, cnt, mine, sp = 0u;
    for (;;) {
        sum = 0u; cnt = 0u; mine = 0u;
#pragma unroll
        for (unsigned j = 0; j < 16; ++j) { const unsigned c = xb_ld(&bar[XB_XCNT(j)]); sum += c; cnt += (c > 0u) ? 1u : 0u; mine = (j == x) ? c : mine; }
        if (sum == G) break;
        __builtin_amdgcn_s_sleep(1);
        if ((++sp & 255u) == 0u) { if (xb_ld(&bar[XB_TMO])) break; if (sp > XB_SPIN_CAP) { atomicAdd(&bar[XB_TMO], 1u); break; } }
    }
    nloc = mine > 0u ? mine : 1u; nx = cnt > 0u ? cnt : 1u;
}

__device__ __forceinline__ void xcd_barrier(const XcdBarrier& b) {
    asm volatile("s_waitcnt vmcnt(0)" ::: "memory");
    __syncthreads();
    if (threadIdx.x == 0) {
        unsigned* bar = b.bar;
        __builtin_amdgcn_s_waitcnt(0);
        unsigned nloc = b.st[0], nx = b.st[1];
        if (nloc == 0u) { xcd_barrier_complete(bar, b.x, nloc, nx); b.st[0] = nloc; b.st[1] = nx; }
        const unsigned old = xb_add(&bar[XB_XSUB(b.x)], 1u);
        const unsigned gen = old / nloc;
        if (old + 1u == (gen + 1u) * nloc) {
            __builtin_amdgcn_fence(__ATOMIC_RELEASE, "agent");
            asm volatile("s_waitcnt vmcnt(0)" ::: "memory");
            const unsigned og = xb_add(&bar[XB_TOP], 1u);
            const unsigned tg = og / nx;
            if (og + 1u == (tg + 1u) * nx) xb_add(&bar[XB_TOPGEN], 1u);
            else XB_SPIN(xb_ld(&bar[XB_TOPGEN]) == tg, bar);
            __builtin_amdgcn_fence(__ATOMIC_ACQUIRE, "agent");
            xb_add(&bar[XB_XGEN(b.x)], 1u);
            asm volatile("s_waitcnt vmcnt(0)" ::: "memory");
        } else {
            XB_SPIN(xb_ld(&bar[XB_XGEN(b.x)]) == gen, bar);
            __builtin_amdgcn_fence(__ATOMIC_ACQUIRE, "agent");
            asm volatile("s_waitcnt vmcnt(0)" ::: "memory");
        }
    }
    __syncthreads();
}


struct Frame {
    LAS unsigned char* lds;
    volatile LAS unsigned* MISC;
    unsigned* ctl;
    unsigned char* ws;
    int tid, lane, wave, G;
    const float* const* in;
};

__device__ __forceinline__ float wave_sum(float v) {
#pragma unroll
    for (int o = 1; o < 64; o <<= 1) v += __shfl_xor(v, o);
    return v;
}
__device__ __forceinline__ float silu_f(float v) { return v / (1.f + __expf(-v)); }

template <bool FP8>
__device__ __forceinline__ void convert_item(const float* W, int K, int N, unsigned char* WT, int rows_total, int row_off, int mode, float scale, LAS unsigned char* scr, int item, int lane) {
    constexpr int KT = FP8 ? 128 : 64;
    const int nblk = N / 64, kt = item / nblk, nb = item - kt * nblk, n0 = 64 * nb;
    const int drow0 = row_off + (mode == 0 ? n0 : ((n0 >> 7) << 8) + (n0 & 127) + (mode == 2 ? 128 : 0));
    const GAS float* src = (const GAS float*)(W + (size_t)(kt * KT) * N + n0) + lane;
    float v[KT];
#pragma unroll
    for (int i = 0; i < KT; ++i) v[i] = src[(size_t)i * N];
    LAS v4u* wrow = (LAS v4u*)(scr + lane * 144);
#pragma unroll
    for (int q = 0; q < 8; ++q) { v4u o;
#pragma unroll
        for (int w = 0; w < 4; ++w) {
            if (FP8) o[w] = pg8::cvt4_fp8(v[16 * q + 4 * w] * scale, v[16 * q + 4 * w + 1] * scale, v[16 * q + 4 * w + 2] * scale, v[16 * q + 4 * w + 3] * scale);
            else o[w] = cvt_pk_bf16(v[(8 * q + 2 * w) % KT], v[(8 * q + 2 * w + 1) % KT]); }
        wrow[q] = o; }
    asm volatile("s_waitcnt lgkmcnt(0)" ::: "memory");
    GAS v4u* dst = (GAS v4u*)(WT + (size_t)kt * rows_total * 128 + (size_t)drow0 * 128) + lane;
    const LAS unsigned char* rrow = scr + (lane >> 3) * 144 + (lane & 7) * 16;
#pragma unroll
    for (int i = 0; i < 8; ++i) dst[64 * i] = *(const LAS v4u*)(rrow + i * 8 * 144);
    asm volatile("s_waitcnt lgkmcnt(0)" ::: "memory");
}

constexpr int I_IN = (1024 / 64) * (3072 / 64), I_GT = (1024 / 64) * (2048 / 64), I_AO = (512 / 64) * (1024 / 64), I_O = (1024 / 64) * (1024 / 64);
constexpr int I_MIX = I_IN + I_GT + 2 * I_AO + I_O;
constexpr int I_FG = (1024 / 64) * (2816 / 64), I_FD = (2816 / 64) * (1024 / 64), I_E = 2 * I_FG + I_FD;
constexpr int I_XG = (1024 / 128) * (2816 / 64), I_XD = (2816 / 128) * (1024 / 64), I_X = 2 * I_XG + I_XD;
constexpr int NDEF = I_E + I_MIX + NEXP * I_X;
__device__ __forceinline__ void mixer_item(Frame& F, int l, int r, LAS unsigned char* scr) {
    unsigned char* wm = F.ws + (l == 0 ? WS_WM0 : WS_WM1);
    if (r < I_IN) { convert_item<false>(F.in[8] + (size_t)l * 1024 * 3072, 1024, 3072, wm + WM_G1, 5120, 0, 0, 1.f, scr, r, F.lane); return; } r -= I_IN;
    if (r < I_GT) { convert_item<false>(F.in[13] + (size_t)l * 1024 * 2048, 1024, 2048, wm + WM_G1, 5120, 3072, 0, 1.f, scr, r, F.lane); return; } r -= I_GT;
    if (r < I_AO) { convert_item<false>(F.in[11] + (size_t)l * 512 * 1024, 512, 1024, wm + WM_A, 1024, 0, 0, 1.f, scr, r, F.lane); return; } r -= I_AO;
    if (r < I_AO) { convert_item<false>(F.in[12] + (size_t)l * 512 * 1024, 512, 1024, wm + WM_C, 1024, 0, 0, 1.f, scr, r, F.lane); return; } r -= I_AO;
    convert_item<false>(F.in[15] + (size_t)l * 1024 * 1024, 1024, 1024, wm + WM_O, 1024, 0, 0, 1.f, scr, r, F.lane);
}
__device__ __forceinline__ void deferred_item(Frame& F, int r, LAS unsigned char* scr) {
    if (r < I_E) {
        if (r < I_FG) { convert_item<false>(F.in[16], 1024, 2816, F.ws + WS_WD + WD_GU, 5632, 0, 1, 1.f, scr, r, F.lane); return; } r -= I_FG;
        if (r < I_FG) { convert_item<false>(F.in[17], 1024, 2816, F.ws + WS_WD + WD_GU, 5632, 0, 2, 1.f, scr, r, F.lane); return; } r -= I_FG;
        convert_item<false>(F.in[18], 2816, 1024, F.ws + WS_WD + WD_DN, 1024, 0, 0, 1.f, scr, r, F.lane); return;
    }
    r -= I_E;
    if (r < I_MIX) { mixer_item(F, 1, r, scr); return; }
    r -= I_MIX;
    const int e = r / I_X; r -= e * I_X;
    if (r < I_XG) { convert_item<true>(F.in[20] + (size_t)e * 1024 * 2816, 1024, 2816, F.ws + WS_WE, NEXP * 5632, e * 5632, 1, S_W, scr, r, F.lane); return; } r -= I_XG;
    if (r < I_XG) { convert_item<true>(F.in[21] + (size_t)e * 1024 * 2816, 1024, 2816, F.ws + WS_WE, NEXP * 5632, e * 5632, 2, S_W, scr, r, F.lane); return; } r -= I_XG;
    convert_item<true>(F.in[22] + (size_t)e * 2816 * 1024, 2816, 1024, F.ws + WS_WED, NEXP * 1024, e * 1024, 0, S_W, scr, r, F.lane);
}
__device__ __forceinline__ void filler(Frame& F, int nwg, int lo, int hi) {
    const int rem = nwg % F.G, c = (int)blockIdx.x;
    if (c < rem) return;
    LAS unsigned char* scr = F.lds + RING_OFF + F.wave * 9216;
    for (int it = lo + (c - rem) * NWAVES + F.wave; it < hi; it += (F.G - rem) * NWAVES) deferred_item(F, it, scr);
    __syncthreads();
}
constexpr int DW_P0 = 0, DW_PB0 = 1400, DW_PD0A = 2600, DW_PD0B = 4052, DW_PE0 = 4852, DW_PG0 = 6252, DW_PH0 = 7552, DW_PB1 = 10952, DW_END = NDEF;
static_assert(DW_PG0 >= I_E && DW_PB1 >= I_E + I_MIX && DW_PB1 < NDEF, "deferred windows: dense FFN weights before PG0, layer-1 mixer weights before PB1");

__device__ __forceinline__ void p0_prologue(Frame& F) {
    const float* c = F.in[1]; const float* cctx = F.in[3]; const float* w_ada = F.in[4]; const float* b_ada = F.in[5];
    float* MOD = (float*)(F.ws + WS_MOD);
    LAS float* sl = (LAS float*)(F.lds);
    LAS float* red = (LAS float*)(F.lds + 9 * 1024 * 4);
    bool have_sl = false;
    for (int it = blockIdx.x; it < 2 * 128; it += F.G) {
        if (!have_sl) { for (int i = F.tid; i < 9 * 1024; i += NWAVES * 64) { const int j = i >> 10, k = i & 1023; sl[i] = silu_f(j < 8 ? c[j * 1024 + k] : cctx[k]); } have_sl = true; }
        __syncthreads();
        const int l = it >> 7, col0 = (it & 127) * 48, cl_ = F.lane < 48 ? F.lane : 47;
        const float* wp = w_ada + (size_t)l * 1024 * 6144 + (size_t)(F.wave * 128) * 6144 + col0 + cl_;
        float a[9];
#pragma unroll
        for (int j = 0; j < 9; ++j) a[j] = 0.f;
#pragma unroll 1
        for (int k0 = 0; k0 < 128; k0 += 32) { float wv[32];
#pragma unroll
            for (int k = 0; k < 32; ++k) wv[k] = wp[(size_t)(k0 + k) * 6144];
#pragma unroll
            for (int k = 0; k < 32; ++k)
#pragma unroll
                for (int j = 0; j < 9; ++j) a[j] += sl[j * 1024 + F.wave * 128 + k0 + k] * wv[k]; }
#pragma unroll
        for (int j = 0; j < 9; ++j) red[(F.wave * 9 + j) * 64 + F.lane] = a[j];
        __syncthreads();
        for (int i = F.tid; i < 9 * 64; i += NWAVES * 64) { const int j = i >> 6, cl = i & 63; if (cl < 48) { float s = 0.f;
#pragma unroll
            for (int w = 0; w < 8; ++w) s += red[(w * 9 + j) * 64 + cl];
            MOD[(size_t)(l * 9 + j) * 6144 + col0 + cl] = s + b_ada[l * 6144 + col0 + cl]; } }
    }
    const int gw = blockIdx.x * NWAVES + F.wave, NGW = F.G * NWAVES;
    __syncthreads();
    LAS unsigned char* scr = F.lds + RING_OFF + F.wave * 9216;
    for (int it = gw; it < I_MIX + DW_PB0; it += NGW) { if (it < I_MIX) mixer_item(F, 0, it, scr); else deferred_item(F, it - I_MIX, scr); }
#ifdef EXP_PH0_IN_P0
    for (int it = DW_PH0 + gw; it < DW_PB1; it += NGW) deferred_item(F, it, scr);
#endif
}

struct RowVec { f32x4 v[4]; };
__device__ __forceinline__ void row_load(RowVec& r, const float* p, int lane) {
    const GAS f32x4* q = (const GAS f32x4*)p + lane;
#pragma unroll
    for (int j = 0; j < 4; ++j) r.v[j] = q[64 * j];
}
__device__ __forceinline__ float row_rms_scale(const RowVec& x) {
    float s = 0.f;
#pragma unroll
    for (int j = 0; j < 4; ++j) s += (x.v[j].x * x.v[j].x + x.v[j].y * x.v[j].y) + (x.v[j].z * x.v[j].z + x.v[j].w * x.v[j].w);
    return rsqrtf(wave_sum(s) * (1.f / D) + EPS);
}
__device__ __forceinline__ void row_store_bf16(const RowVec& r, bf16* p, int lane) {
    GAS v2u* o = (GAS v2u*)p + lane;
#pragma unroll
    for (int j = 0; j < 4; ++j) { v2u w; w.x = cvt_pk_bf16(r.v[j].x, r.v[j].y); w.y = cvt_pk_bf16(r.v[j].z, r.v[j].w); o[64 * j] = w; }
}
__device__ __forceinline__ void row_store_fp8(const RowVec& r, unsigned char* p, int lane, float scale) {
    GAS unsigned* o = (GAS unsigned*)p + lane;
#pragma unroll
    for (int j = 0; j < 4; ++j) o[64 * j] = pg8::cvt4_fp8(r.v[j].x * scale, r.v[j].y * scale, r.v[j].z * scale, r.v[j].w * scale);
}
__device__ __forceinline__ const float* xrow_ptr(Frame& F, bool from_input, int row) {
    if (from_input) return row < TLAT ? F.in[0] + (size_t)row * D : F.in[2] + (size_t)(row - TLAT) * D;
    return (const float*)(F.ws + WS_X) + (size_t)row * D;
}
template <bool FP8OUT = false>
__device__ __forceinline__ void modulate_phase(Frame& F, bool from_input, const float* gain, const float* modl  , int sh_off, int sc_off, bf16* H, int nrows) {
    const int gw = blockIdx.x * NWAVES + F.wave, NGW = F.G * NWAVES;
    const int per = (nrows + NGW - 1) / NGW;
    RowVec g, sh, sc; row_load(g, gain, F.lane);
    int cur_b = -1;
    for (int i = 0; i < per; ++i) {
        const int row = gw * per + i; if (row >= nrows) break;
        const int b = row < TLAT ? row / SEQ : 8;
        if (b != cur_b) { row_load(sh, modl + (size_t)b * 6144 + sh_off, F.lane); row_load(sc, modl + (size_t)b * 6144 + sc_off, F.lane); cur_b = b; }
        RowVec x; row_load(x, xrow_ptr(F, from_input, row), F.lane);
        const float r = row_rms_scale(x);
#pragma unroll
        for (int j = 0; j < 4; ++j) x.v[j] = x.v[j] * r * g.v[j] * (1.f + sc.v[j]) + sh.v[j];
        if (FP8OUT) row_store_fp8(x, (unsigned char*)H + (size_t)row * D, F.lane, S_H2); else row_store_bf16(x, H + (size_t)row * D, F.lane);
    }
}

namespace att {
constexpr int KP = 144;
constexpr int BLK_B = 64 * KP;
constexpr int OFF_K = 0, OFF_V = 4 * BLK_B, OFF_BIAS = 8 * BLK_B, ATT_LDS = OFF_BIAS + 2048;
__device__ __forceinline__ int pos32(int k) { const int s = k >> 4, k16 = k & 15; return 16 * s + 8 * ((k16 >> 2) & 1) + (((k16 >> 3) << 2) | (k16 & 3)); }
__device__ __forceinline__ int clampi(int v, int lo, int hi) { return v < lo ? lo : (v > hi ? hi : v); }
#define MFMA32(a, b, c) __builtin_amdgcn_mfma_f32_32x32x16_bf16((a), (b), (c), 0, 0, 0)

template <bool CTXQ>
__device__ __forceinline__ void attn_unit(LAS unsigned char* sm, const bf16* __restrict__ P1, bf16* __restrict__ YA, const float* __restrict__ rpb_lh, int b, int h, int r0) {
    const int tid = threadIdx.x, lane = tid & 63, l32 = lane & 31, hi = lane >> 5; const int wid = __builtin_amdgcn_readfirstlane(tid >> 6);
    const int R_lo = CTXQ ? 0 : clampi(r0 - 4, 0, 24);
    const int n_loc = CTXQ ? 0 : (clampi(r0 - 1, 0, 24) + 8 - R_lo);
    const int nb = n_loc + 4, nsteps = (nb + 1) >> 1;
    const int rp = wid >> 2, cb = wid & 3;
    const int qrow = r0 + 2 * rp + (l32 >> 4), qc = 16 * cb + (l32 & 15);
    const int a0 = clampi(16 * cb - 8, 0, 32);
    const int w_lo = clampi(r0 + 2 * rp - 4, 0, 24), w_hi = clampi(r0 + 2 * rp + 1 - 4, 0, 24) + 8;
    const int my_rs = clampi(qrow - 4, 0, 24), cs = clampi(qc - 8, 0, 48);
    const size_t qtok = CTXQ ? (size_t)(TLAT + b * CTXL + wid * 32 + l32) : (size_t)(b * SEQ + qrow * 64 + qc);
    if (!CTXQ) { if (tid < 465) ((LAS float*)(sm + OFF_BIAS))[tid] = rpb_lh[tid] * LOG2E; }
    bf16x8 qr[4];
#pragma unroll
    for (int kk = 0; kk < 4; ++kk) qr[kk] = *(const bf16x8*)(P1 + qtok * PW + h * HDIM + kk * 16 + hi * 8);
    const int skey = tid >> 3, sch = tid & 7;
    const int tq = (lane & 15) >> 2, tofs = 32 * ((lane >> 4) & 1) + 8 * (lane & 3);
    const unsigned kw_off = OFF_K + skey * KP + sch * 16, vw_off = OFF_V + skey * KP + sch * 16;
    const bf16* const sbase = P1 + (size_t)skey * PW + h * HDIM + sch * 8;
#define BLK_TOK(t) ((t) < n_loc ? (size_t)(b * SEQ + (R_lo + (t)) * 64) : (size_t)(TLAT + b * CTXL + ((t) - n_loc) * 64))
#define STAGE_LOAD(st) do { _Pragma("unroll") for (int s_ = 0; s_ < 2; ++s_) { const int t_ = 2 * (st) + s_; if (t_ < nb) { const bf16* src_ = sbase + BLK_TOK(t_) * PW; kreg[s_] = *(const v4u*)(src_ + AW); vreg[s_] = *(const v4u*)(src_ + 2 * AW); } } } while (0)
#define STAGE_WRITE(st, buf) do { _Pragma("unroll") for (int s_ = 0; s_ < 2; ++s_) { if (2 * (st) + s_ < nb) { *(LAS v4u*)(sm + kw_off + ((buf) * 2 + s_) * BLK_B) = kreg[s_]; *(LAS v4u*)(sm + vw_off + ((buf) * 2 + s_) * BLK_B) = vreg[s_]; } } } while (0)
#define VFRAG(dst, vb_, dh_, a_, s2_) do { const LAS unsigned char* vp_ = (vb_) + ((a_) + 16 * (s2_) + 4 * hi + tq) * KP + 64 * (dh_) + tofs; \
        const s16x4 lo_ = __builtin_bit_cast(s16x4, __builtin_amdgcn_ds_read_tr16_b64_v4i16((LAS s16x4*)vp_)), hi_ = __builtin_bit_cast(s16x4, __builtin_amdgcn_ds_read_tr16_b64_v4i16((LAS s16x4*)(vp_ + 8 * KP))); \
        dst = __builtin_shufflevector(lo_, hi_, 0, 1, 2, 3, 4, 5, 6, 7); } while (0)
#define PACK8(dst, x_, o_) do { v4u w_; w_.x = cvt_pk_bf16(x_[(o_) + 0], x_[(o_) + 1]); w_.y = cvt_pk_bf16(x_[(o_) + 2], x_[(o_) + 3]); w_.z = cvt_pk_bf16(x_[(o_) + 4], x_[(o_) + 5]); w_.w = cvt_pk_bf16(x_[(o_) + 6], x_[(o_) + 7]); dst = __builtin_bit_cast(bf16x8, w_); } while (0)
    v4u kreg[2], vreg[2];
    STAGE_LOAD(0); STAGE_WRITE(0, 0);
    __syncthreads();
    float m = -1e30f, lsum = 0.f; f32x16 o[2];
#pragma unroll
    for (int r = 0; r < 16; ++r) { o[0][r] = 0.f; o[1][r] = 0.f; }
    for (int st = 0; st < nsteps; ++st) {
        const int buf = st & 1;
        if (st + 1 < nsteps) STAGE_LOAD(st + 1);
#pragma unroll 1
        for (int s = 0; s < 2; ++s) {
            const int t = 2 * st + s; if (t >= nb) break;
            const LAS unsigned char* kb = sm + OFF_K + (buf * 2 + s) * BLK_B; const LAS unsigned char* vb = sm + OFF_V + (buf * 2 + s) * BLK_B;
            if (!CTXQ && t < n_loc) {
                const int keyrow = R_lo + t;
                if (keyrow < w_lo || keyrow >= w_hi) continue;
                f32x16 sp;
#pragma unroll
                for (int r = 0; r < 16; ++r) sp[r] = 0.f;
#pragma unroll
                for (int kk = 0; kk < 4; ++kk) { const bf16x8 a = *(const LAS bf16x8*)(kb + (a0 + l32) * KP + kk * 32 + hi * 16); sp = MFMA32(a, qr[kk], sp); }
                const LAS float* brow = (const LAS float*)(sm + OFF_BIAS) + ((keyrow - qrow + 7) * 31 + 15 + a0 + 4 * hi - qc);
                const int wofs = ((unsigned)(keyrow - my_rs) < 8u) ? (a0 + 4 * hi - cs) : 4096;
                float bv[16];
#pragma unroll
                for (int r = 0; r < 16; ++r) bv[r] = brow[(r & 3) + 8 * (r >> 2)];
                asm volatile("" : "+v"(bv[0]), "+v"(bv[1]), "+v"(bv[2]), "+v"(bv[3]), "+v"(bv[4]), "+v"(bv[5]), "+v"(bv[6]), "+v"(bv[7]), "+v"(bv[8]), "+v"(bv[9]), "+v"(bv[10]), "+v"(bv[11]), "+v"(bv[12]), "+v"(bv[13]), "+v"(bv[14]), "+v"(bv[15]));
#pragma unroll
                for (int r = 0; r < 16; ++r) { const bool inw = (unsigned)((r & 3) + 8 * (r >> 2) + wofs) < 16u; sp[r] = inw ? sp[r] + bv[r] : -3e38f; }
                float mx = sp[0];
#pragma unroll
                for (int r = 1; r < 16; ++r) mx = fmaxf(mx, sp[r]);
                mx = fmaxf(mx, __shfl_xor(mx, 32));
                const float mn = fmaxf(m, mx), alpha = __builtin_amdgcn_exp2f(m - mn); m = mn;
                float ps = 0.f;
#pragma unroll
                for (int r = 0; r < 16; ++r) { sp[r] = __builtin_amdgcn_exp2f(sp[r] - mn); ps += sp[r]; }
                lsum = lsum * alpha + ps;
#pragma unroll
                for (int r = 0; r < 16; ++r) { o[0][r] *= alpha; o[1][r] *= alpha; }
                bf16x8 pb[2]; PACK8(pb[0], sp, 0); PACK8(pb[1], sp, 8);
#pragma unroll
                for (int dh = 0; dh < 2; ++dh)
#pragma unroll
                    for (int s2 = 0; s2 < 2; ++s2) { bf16x8 a; VFRAG(a, vb, dh, a0, s2); o[dh] = MFMA32(a, pb[s2], o[dh]); }
            } else {
                f32x16 sp[2];
#pragma unroll
                for (int p = 0; p < 2; ++p) {
#pragma unroll
                    for (int r = 0; r < 16; ++r) sp[p][r] = 0.f;
#pragma unroll
                    for (int kk = 0; kk < 4; ++kk) { const bf16x8 a = *(const LAS bf16x8*)(kb + (32 * p + l32) * KP + kk * 32 + hi * 16); sp[p] = MFMA32(a, qr[kk], sp[p]); }
                }
                float mx = sp[0][0];
#pragma unroll
                for (int r = 1; r < 16; ++r) mx = fmaxf(mx, sp[0][r]);
#pragma unroll
                for (int r = 0; r < 16; ++r) mx = fmaxf(mx, sp[1][r]);
                mx = fmaxf(mx, __shfl_xor(mx, 32));
                const float mn = fmaxf(m, mx), alpha = __builtin_amdgcn_exp2f(m - mn); m = mn;
                float ps = 0.f;
#pragma unroll
                for (int p = 0; p < 2; ++p)
#pragma unroll
                    for (int r = 0; r < 16; ++r) { sp[p][r] = __builtin_amdgcn_exp2f(sp[p][r] - mn); ps += sp[p][r]; }
                lsum = lsum * alpha + ps;
#pragma unroll
                for (int r = 0; r < 16; ++r) { o[0][r] *= alpha; o[1][r] *= alpha; }
                bf16x8 pb[2][2]; PACK8(pb[0][0], sp[0], 0); PACK8(pb[0][1], sp[0], 8); PACK8(pb[1][0], sp[1], 0); PACK8(pb[1][1], sp[1], 8);
#pragma unroll
                for (int dh = 0; dh < 2; ++dh)
#pragma unroll
                    for (int p = 0; p < 2; ++p)
#pragma unroll
                        for (int s2 = 0; s2 < 2; ++s2) { bf16x8 a; VFRAG(a, vb, dh, 32 * p, s2); o[dh] = MFMA32(a, pb[p][s2], o[dh]); }
            }
        }
        if (st + 1 < nsteps) STAGE_WRITE(st + 1, buf ^ 1);
        __syncthreads();
    }
    const float ltot = lsum + __shfl_xor(lsum, 32), inv = 1.f / ltot;
    bf16* yrow = YA + qtok * AW + h * HDIM + 4 * hi;
#pragma unroll
    for (int dh = 0; dh < 2; ++dh)
#pragma unroll
        for (int g = 0; g < 4; ++g) { v2u w; w.x = cvt_pk_bf16(o[dh][4 * g] * inv, o[dh][4 * g + 1] * inv); w.y = cvt_pk_bf16(o[dh][4 * g + 2] * inv, o[dh][4 * g + 3] * inv);
            *(v2u*)(yrow + 32 * dh + 8 * g) = w; }
#undef BLK_TOK
#undef STAGE_LOAD
#undef STAGE_WRITE
#undef VFRAG
#undef PACK8
}
}

__device__ __forceinline__ void conv_phase(Frame& F, const bf16* P1, bf16* YC, const float* wconv  , int nrows) {
    const int gw = blockIdx.x * NWAVES + F.wave, NGW = F.G * NWAVES, ch0 = F.lane * 8;
    float w0[8], w1[8], w2[8];
#pragma unroll
    for (int i = 0; i < 8; ++i) { w0[i] = wconv[ch0 + i]; w1[i] = wconv[CW + ch0 + i]; w2[i] = wconv[2 * CW + ch0 + i]; }
    for (int ck = gw; ck < nrows / 8; ck += NGW) {
        const int t0 = ck * 8; const int seq = t0 < TLAT ? SEQ : CTXL;
        const bool has_prev = (t0 % seq) != 0, has_next = ((t0 + 8) % seq) != 0;
        v4u cgv[10], uv[10], bgv[8];
#pragma unroll
        for (int i = 0; i < 10; ++i) { const int row = t0 - 1 + i; const bool ok = (i > 0 || has_prev) && (i < 9 || has_next);
            if (ok) { cgv[i] = *(const v4u*)(P1 + (size_t)row * PW + 3 * AW + CW + ch0); uv[i] = *(const v4u*)(P1 + (size_t)row * PW + 3 * AW + 2 * CW + ch0); }
            else { cgv[i] = (v4u){0u, 0u, 0u, 0u}; uv[i] = (v4u){0u, 0u, 0u, 0u}; } }
#pragma unroll
        for (int i = 0; i < 8; ++i) bgv[i] = *(const v4u*)(P1 + (size_t)(t0 + i) * PW + 3 * AW + ch0);
        float zp[8], zc[8], zn[8];
#define MKZ(dst, a_, b_) do { dst[0] = bf_lo(a_.x) * bf_lo(b_.x); dst[1] = bf_hi(a_.x) * bf_hi(b_.x); dst[2] = bf_lo(a_.y) * bf_lo(b_.y); dst[3] = bf_hi(a_.y) * bf_hi(b_.y); \
        dst[4] = bf_lo(a_.z) * bf_lo(b_.z); dst[5] = bf_hi(a_.z) * bf_hi(b_.z); dst[6] = bf_lo(a_.w) * bf_lo(b_.w); dst[7] = bf_hi(a_.w) * bf_hi(b_.w); } while (0)
        MKZ(zp, cgv[0], uv[0]); MKZ(zc, cgv[1], uv[1]);
#pragma unroll
        for (int i8 = 0; i8 < 8; ++i8) {
            MKZ(zn, cgv[i8 + 2], uv[i8 + 2]);
            const v4u g_ = bgv[i8];
            const float bgf[8] = {bf_lo(g_.x), bf_hi(g_.x), bf_lo(g_.y), bf_hi(g_.y), bf_lo(g_.z), bf_hi(g_.z), bf_lo(g_.w), bf_hi(g_.w)};
            float y[8];
#pragma unroll
            for (int i = 0; i < 8; ++i) y[i] = bgf[i] * (w0[i] * zp[i] + w1[i] * zc[i] + w2[i] * zn[i]);
            v4u w; w.x = cvt_pk_bf16(y[0], y[1]); w.y = cvt_pk_bf16(y[2], y[3]); w.z = cvt_pk_bf16(y[4], y[5]); w.w = cvt_pk_bf16(y[6], y[7]);
            *(v4u*)(YC + (size_t)(t0 + i8) * CW + ch0) = w;
#pragma unroll
            for (int i = 0; i < 8; ++i) { zp[i] = zc[i]; zc[i] = zn[i]; }
        }
#undef MKZ
    }
}

__device__ __forceinline__ void router_phase(Frame& F, const float* gain, const float* modl, const float* w_router) {
    LAS float* wr = (LAS float*)(F.lds);
    LAS unsigned* lc = (LAS unsigned*)(F.lds + 32768);
    LAS unsigned* tk = (LAS unsigned*)(F.lds + 32768 + 64);
    for (int i = F.tid; i < 1024 * 8; i += NWAVES * 64) wr[i] = w_router[i];
    if (F.tid < 8) lc[F.tid] = 0u;
    __syncthreads();
    unsigned* R = (unsigned*)(F.ws + WS_ROUTE);
    RowVec g, sh, sc; row_load(g, gain, F.lane);
    int cur_b = -1;
    for (int base = blockIdx.x * 64; base < TLAT; base += F.G * 64) {
#pragma unroll 1
        for (int i = 0; i < 8; ++i) {
            const int ti = F.wave * 8 + i, row = base + ti, b = row / SEQ;
            if (b != cur_b) { row_load(sh, modl + (size_t)b * 6144 + 3 * D, F.lane); row_load(sc, modl + (size_t)b * 6144 + 4 * D, F.lane); cur_b = b; }
            RowVec x; row_load(x, (const float*)(F.ws + WS_X) + (size_t)row * D, F.lane);
            const float r = row_rms_scale(x);
            float lg[8];
#pragma unroll
            for (int e = 0; e < 8; ++e) lg[e] = 0.f;
#pragma unroll
            for (int j = 0; j < 4; ++j) { const f32x4 hv = x.v[j] * r * g.v[j] * (1.f + sc.v[j]) + sh.v[j]; x.v[j] = hv;
#pragma unroll
                for (int q = 0; q < 4; ++q) { const LAS f32x4* wq = (const LAS f32x4*)(wr + (256 * j + 4 * F.lane + q) * 8); const f32x4 wa = wq[0], wb = wq[1];
                    lg[0] += hv[q] * wa.x; lg[1] += hv[q] * wa.y; lg[2] += hv[q] * wa.z; lg[3] += hv[q] * wa.w; lg[4] += hv[q] * wb.x; lg[5] += hv[q] * wb.y; lg[6] += hv[q] * wb.z; lg[7] += hv[q] * wb.w; } }
            row_store_fp8(x, F.ws + WS_YE + (size_t)row * D, F.lane, S_H2);
#pragma unroll
            for (int e = 0; e < 8; ++e) lg[e] = wave_sum(lg[e]);
            int i1 = 0; float v1 = lg[0];
#pragma unroll
            for (int e = 1; e < 8; ++e) if (lg[e] > v1) { v1 = lg[e]; i1 = e; }
            int i2 = -1; float v2 = -3e38f;
#pragma unroll
            for (int e = 0; e < 8; ++e) if (e != i1 && lg[e] > v2) { v2 = lg[e]; i2 = e; }
            if (F.lane == 0) {
                const float e2 = __expf(v2 - v1), p1 = 1.f / (1.f + e2), p2 = e2 * p1;
                const unsigned lp1 = __hip_atomic_fetch_add(lc + i1, 1u, __ATOMIC_RELAXED, __HIP_MEMORY_SCOPE_WORKGROUP), lp2 = __hip_atomic_fetch_add(lc + i2, 1u, __ATOMIC_RELAXED, __HIP_MEMORY_SCOPE_WORKGROUP);
                tk[ti * 6 + 0] = (unsigned)i1; tk[ti * 6 + 1] = (unsigned)i2; tk[ti * 6 + 2] = lp1; tk[ti * 6 + 3] = lp2; tk[ti * 6 + 4] = __float_as_uint(p1); tk[ti * 6 + 5] = __float_as_uint(p2);
            }
        }
        __syncthreads();
        if (F.tid < 8) lc[8 + F.tid] = __hip_atomic_fetch_add(F.ctl + CW_FILL + 64 * F.tid, lc[F.tid], RLX_AGENT);
        __syncthreads();
        if (F.tid < 64) { const int row = base + F.tid; const unsigned e1 = tk[F.tid * 6], e2 = tk[F.tid * 6 + 1];
            R[row] = e1 | (e2 << 8); R[TLAT + row] = lc[8 + e1] + tk[F.tid * 6 + 2]; R[2 * TLAT + row] = lc[8 + e2] + tk[F.tid * 6 + 3]; R[3 * TLAT + row] = tk[F.tid * 6 + 4]; R[4 * TLAT + row] = tk[F.tid * 6 + 5]; }
        __syncthreads();
        if (F.tid < 8) lc[F.tid] = 0u;
        __syncthreads();
    }
}
__device__ __forceinline__ void moe_table(Frame& F, LAS int* tab) {
    if (F.tid == 0) { int acc = 0;
        for (int e = 0; e < 8; ++e) { tab[e] = acc; const unsigned c = __hip_atomic_load(F.ctl + CW_FILL + 64 * e, RLX_AGENT); acc += (int)((c + 255u) >> 8); }
        tab[8] = acc; }
    __syncthreads();
}
__device__ __forceinline__ void scatter_h2_phase(Frame& F, LAS int* tab) {
    const unsigned* R = (const unsigned*)(F.ws + WS_ROUTE);
    unsigned char* H2P = F.ws + WS_RA; const unsigned char* H2T = F.ws + WS_YE;
    const int gw = blockIdx.x * NWAVES + F.wave, NGW = F.G * NWAVES;
    for (int row0 = gw * 4; row0 < TLAT; row0 += NGW * 4) {
        v4u v[4]; size_t s1[4], s2[4];
#pragma unroll
        for (int i = 0; i < 4; ++i) { const int row = row0 + i; v[i] = *(const GAS v4u*)(H2T + (size_t)row * D + F.lane * 16);
            const unsigned ee = R[row]; const int e1 = ee & 255u, e2 = ee >> 8;
            s1[i] = (size_t)tab[e1] * 256 + R[TLAT + row]; s2[i] = (size_t)tab[e2] * 256 + R[2 * TLAT + row]; }
#pragma unroll
        for (int i = 0; i < 4; ++i) { *(GAS v4u*)(H2P + s1[i] * D + F.lane * 16) = v[i]; *(GAS v4u*)(H2P + s2[i] * D + F.lane * 16) = v[i]; }
    }
}
__device__ __forceinline__ void final_phase(Frame& F, const float* modl, const float* gfin, float* out, LAS int* tab) {
    const unsigned* R = (const unsigned*)(F.ws + WS_ROUTE);
    const bf16* YE = (const bf16*)(F.ws + WS_YE);
    const int gw = blockIdx.x * NWAVES + F.wave, NGW = F.G * NWAVES, per = (TLAT + NGW - 1) / NGW;
    RowVec g, g2; row_load(g, gfin, F.lane);
    int cur_b = -1;
    for (int i = 0; i < per; ++i) {
        const int row = gw * per + i; if (row >= TLAT) break;
        const int b = row / SEQ;
        if (b != cur_b) { row_load(g2, modl + (size_t)b * 6144 + 5 * D, F.lane); cur_b = b; }
        RowVec x; row_load(x, (const float*)(F.ws + WS_X) + (size_t)row * D, F.lane);
        const unsigned ee = R[row]; const int e1 = ee & 255u, e2 = ee >> 8;
        const size_t s1 = (size_t)tab[e1] * 256 + R[TLAT + row], s2 = (size_t)tab[e2] * 256 + R[2 * TLAT + row];
        const float p1 = __uint_as_float(R[3 * TLAT + row]), p2 = __uint_as_float(R[4 * TLAT + row]);
        const GAS v2u* y1 = (const GAS v2u*)(YE + s1 * D) + F.lane; const GAS v2u* y2 = (const GAS v2u*)(YE + s2 * D) + F.lane;
#pragma unroll
        for (int j = 0; j < 4; ++j) { const v2u a = y1[64 * j], c = y2[64 * j];
            f32x4 y; y.x = p1 * bf_lo(a.x) + p2 * bf_lo(c.x); y.y = p1 * bf_hi(a.x) + p2 * bf_hi(c.x); y.z = p1 * bf_lo(a.y) + p2 * bf_lo(c.y); y.w = p1 * bf_hi(a.y) + p2 * bf_hi(c.y);
            x.v[j] = x.v[j] + g2.v[j] * y; }
        const float r = row_rms_scale(x);
        GAS f32x4* o = (GAS f32x4*)(out + (size_t)row * D) + F.lane;
#pragma unroll
        for (int j = 0; j < 4; ++j) o[64 * j] = x.v[j] * r * g.v[j];
    }
}


#ifndef REPEAT_MASK
#define REPEAT_MASK 0u
#endif
#ifndef REPEAT_EXTRA
#define REPEAT_EXTRA 2
#endif
#ifndef PH_MASK
#define PH_MASK 0xFFFFFu
#endif
#define PH_ON(k) (((PH_MASK) >> (k)) & 1u)
#define IN(k) (lo <= (k) && (k) < hi)
#define BOTH(k) (IN(k) && IN((k) + 1))
#define GRID_BAR() do { if (N_LAUNCHES == 1) xcd_barrier(bar); } while (0)
template <int L>
__device__ __forceinline__ void mixer_layer(Frame& F, const XcdBarrier& bar, int lo, int hi) {
    constexpr int pb = 1 + 9 * L;
    constexpr int mrows = (L == 0) ? TALL : TLAT;
    if (PH_ON(pb) && IN(pb)) { modulate_phase<(PB1_FP8 && L == 1)>(F, L == 0, F.in[6] + L * D, (const float*)(F.ws + WS_MOD) + (size_t)L * 9 * 6144, 0, D, (bf16*)(F.ws + WS_RA), TALL); if (BOTH(pb)) GRID_BAR(); }
    if (PH_ON(pb + 1) && IN(pb + 1)) {
        constexpr bool F8 = PB1_FP8 && L == 1;
        pg8::Gemm g{(const bf16*)(F.ws + WS_RA), (const bf16*)(F.ws + (L == 0 ? WS_WM0 : WS_WM1) + WM_G1), TALL, 5120, F8 ? 512 : 1024, (size_t)5120 * 128};
        pg8::EpiProj E{(bf16*)(F.ws + WS_RB), (bf16*)(F.ws + WS_GT), F.in[14] + L * GW, 0.125f * LOG2E, F8 ? 1.f / (S_H2 * S_W) : 1.f};
        if (L == 0) { pg8::StaticOrder S; S.init(TALL, 5120, F.G, (int)blockIdx.x); pg8::gemm_phase<pg8::EpiProj, pg8::StaticOrder, PG8_ALIGN, PG8_SP2>(F.lds + RING_OFF, g, S, E); filler(F, TALL / 256 * 20, DW_PB0, DW_PD0A); }
        else { pg8::ProjL1Order S; S.init(F.G, (int)blockIdx.x); pg8::gemm_phase<pg8::EpiProj, pg8::ProjL1Order, PG8_ALIGN, PG8_SP2, F8>(F.lds + RING_OFF, g, S, E); filler(F, 64 * 20 + 32, DW_PB1, DW_END); }
        if (BOTH(pb + 1)) GRID_BAR();
    }
    if (PH_ON(pb + 2) && IN(pb + 2)) {
        const bf16* P1 = (const bf16*)(F.ws + WS_RB); bf16* YA = (bf16*)(F.ws + WS_RA); bf16* YC = (bf16*)(F.ws + WS_RA + (size_t)TALL * AW * 2);
        const float* rpb = F.in[10] + (size_t)L * NHEAD * 465;
#ifndef ATT_REPS
#define ATT_REPS 1
#endif
#ifndef CONV_REPS
#define CONV_REPS 1
#endif
        for (int rep = 0; rep < ATT_REPS; ++rep) {
        for (int u = blockIdx.x; u < 512; u += F.G) { const int b = u >> 6, h = (u >> 3) & 7, r0 = (u & 7) * 4; att::attn_unit<false>(F.lds + RING_OFF, P1, YA, rpb + h * 465, b, h, r0); }
        if (L == 0) for (int v = (int)blockIdx.x - (F.G - 64); v >= 0 && v < 64; v += F.G) att::attn_unit<true>(F.lds + RING_OFF, P1, YA, rpb, v >> 3, v & 7, 0);
        }
        for (int rep = 0; rep < CONV_REPS; ++rep) conv_phase(F, P1, YC, F.in[9] + (size_t)L * 3 * CW, mrows);
        if (BOTH(pb + 2)) GRID_BAR();
    }
    if (PH_ON(pb + 3) && IN(pb + 3)) {
        const unsigned char* wm = F.ws + (L == 0 ? WS_WM0 : WS_WM1);
        bf16* MG = (bf16*)(F.ws + WS_RB); const bf16* GT = (const bf16*)(F.ws + WS_GT);
        pg8::StaticOrder S; S.init(mrows, 1024, F.G, (int)blockIdx.x);
        { pg8::Gemm g{(const bf16*)(F.ws + WS_RA), (const bf16*)(wm + WM_A), mrows, 1024, 512, (size_t)1024 * 128}; pg8::EpiMerge<false> E{MG, GT, 0};
          pg8::gemm_phase<pg8::EpiMerge<false>, pg8::StaticOrder, PG8_ALIGN, PG8_SP2>(F.lds + RING_OFF, g, S, E); if (L == 0) filler(F, TALL / 256 * 4, DW_PD0A, DW_PD0B); }
        { pg8::Gemm g{(const bf16*)(F.ws + WS_RA + (size_t)TALL * AW * 2), (const bf16*)(wm + WM_C), mrows, 1024, 512, (size_t)1024 * 128}; pg8::EpiMerge<true> E{MG, GT, 1024};
          pg8::gemm_phase<pg8::EpiMerge<true>, pg8::StaticOrder, PG8_ALIGN, PG8_SP2>(F.lds + RING_OFF, g, S, E); if (L == 0) filler(F, TALL / 256 * 4, DW_PD0B, DW_PE0); }
        if (BOTH(pb + 3)) GRID_BAR();
    }
    if (PH_ON(pb + 4) && IN(pb + 4)) {
        float* X = (float*)(F.ws + WS_X);
        pg8::StaticOrder S; S.init(mrows, 1024, F.G, (int)blockIdx.x);
        pg8::Gemm g{(const bf16*)(F.ws + WS_RB), (const bf16*)(F.ws + (L == 0 ? WS_WM0 : WS_WM1) + WM_O), mrows, 1024, 1024, (size_t)1024 * 128};
        pg8::EpiResid E{L == 0 ? F.in[0] : X, L == 0 ? F.in[2] : X + (size_t)TLAT * D, X, (const float*)(F.ws + WS_MOD) + (size_t)L * 9 * 6144 + 2 * D};
        pg8::gemm_phase<pg8::EpiResid, pg8::StaticOrder, PG8_ALIGN, PG8_SP2>(F.lds + RING_OFF, g, S, E);
        if (L == 0) filler(F, TALL / 256 * 4, DW_PE0, DW_PG0);
        if (BOTH(pb + 4)) GRID_BAR();
    }
}
struct Args { const float* in[24]; float* out; unsigned char* ws; int ph_lo, ph_hi; };
__global__ void __launch_bounds__(NWAVES * 64, 2) fwd(Args args) {
    extern __shared__ __attribute__((aligned(16))) unsigned char lds[];
    Frame F;
    F.lds = (LAS unsigned char*)lds;
    F.MISC = (volatile LAS unsigned*)(F.lds + MISC_OFF);
    F.tid = threadIdx.x; F.lane = F.tid & 63; F.wave = __builtin_amdgcn_readfirstlane(F.tid >> 6);
    F.G = gridDim.x; F.ws = args.ws; F.ctl = (unsigned*)(args.ws + WS_CTL); F.in = args.in;
    for (int u = F.tid; u < (LDS_BYTES - LDSCTL_OFF) / 4; u += NWAVES * 64) ((LAS unsigned*)(F.lds + LDSCTL_OFF))[u] = 0u;
    __syncthreads();
    XcdBarrier bar; bar.bar = F.ctl + CW_BAR; bar.x = 0; bar.st = nullptr;
    if (N_LAUNCHES == 1) bar = xcd_barrier_post(F.ctl + CW_BAR, F.MISC + 8);
    const int lo = args.ph_lo, hi = args.ph_hi;
    float* X = (float*)(F.ws + WS_X);
    const float* MOD = (const float*)(F.ws + WS_MOD);
    LAS int* tab = (LAS int*)(F.lds + LDSCTL_OFF + 64);

    if (PH_ON(0) && IN(0)) { p0_prologue(F); if (BOTH(0)) GRID_BAR(); }
    mixer_layer<0>(F, bar, lo, hi);
    if (PH_ON(6) || PH_ON(7) || PH_ON(8)) {
        const float* modl = MOD; bf16* H2 = (bf16*)(F.ws + WS_RA); bf16* HID = (bf16*)(F.ws + WS_RB);
        if (PH_ON(6) && IN(6)) { modulate_phase(F, false, F.in[7], modl, 3 * D, 4 * D, H2, TALL); if (BOTH(6)) GRID_BAR(); }
        if (PH_ON(7) && IN(7)) {
            pg8::StaticOrder S; S.init(TALL, 5632, F.G, (int)blockIdx.x);
            pg8::Gemm g{H2, (const bf16*)(F.ws + WS_WD + WD_GU), TALL, 5632, 1024, (size_t)5632 * 128}; pg8::EpiSwiGLU E{HID};
            pg8::gemm_phase<pg8::EpiSwiGLU, pg8::StaticOrder, PG8_ALIGN, PG8_SP2>(F.lds + RING_OFF, g, S, E);
            filler(F, TALL / 256 * 22, DW_PG0, DW_PH0);
            if (BOTH(7)) GRID_BAR();
        }
        if (PH_ON(8) && IN(8)) {
            pg8::StaticOrder S; S.init(TALL, 1024, F.G, (int)blockIdx.x);
            pg8::Gemm g{HID, (const bf16*)(F.ws + WS_WD + WD_DN), TALL, 1024, 2816, (size_t)1024 * 128};
            pg8::EpiResid E{X, X + (size_t)TLAT * D, X, modl + 5 * D};
            pg8::gemm_phase<pg8::EpiResid, pg8::StaticOrder, PG8_ALIGN, PG8_SP2>(F.lds + RING_OFF, g, S, E);
#ifndef EXP_PH0_IN_P0
            filler(F, TALL / 256 * 4, DW_PH0, DW_PB1);
#endif
            if (BOTH(8)) GRID_BAR();
        }
    }
    mixer_layer<1>(F, bar, lo, hi);
    {
        const float* modl = MOD + (size_t)9 * 6144;
        if (PH_ON(15) && IN(15)) { router_phase(F, F.in[7] + D, modl, F.in[19]); if (BOTH(15)) GRID_BAR(); }
        if (PH_ON(16) && IN(16)) { moe_table(F, tab); scatter_h2_phase(F, tab); if (BOTH(16)) GRID_BAR(); }
        if (PH_ON(17) && IN(17)) {
            moe_table(F, tab);
            pg8::MoEOrder S{tab, 22, F.G, (int)((blockIdx.x & 7) * (F.G >> 3) + (blockIdx.x >> 3))};
            pg8::Gemm g{(const bf16*)(F.ws + WS_RA), (const bf16*)(F.ws + WS_WE), SLOTS_MAX, 8 * 5632, 512, (size_t)NEXP * 5632 * 128}; pg8::EpiSwiGLU8 E{F.ws + WS_RB, 1.f / (S_H2 * S_W), S_HID};
            pg8::gemm_phase<pg8::EpiSwiGLU8, pg8::MoEOrder, PG8_ALIGN, PG8_SP2, true>(F.lds + RING_OFF, g, S, E);
            if (BOTH(17)) GRID_BAR();
        }
        if (PH_ON(18) && IN(18)) {
            moe_table(F, tab);
            pg8::MoEOrder S{tab, 4, F.G, (int)((blockIdx.x & 7) * (F.G >> 3) + (blockIdx.x >> 3))};
            pg8::Gemm g{(const bf16*)(F.ws + WS_RB), (const bf16*)(F.ws + WS_WED), SLOTS_MAX, 8 * 1024, 1408, (size_t)NEXP * 1024 * 128}; pg8::EpiYE E{(bf16*)(F.ws + WS_YE), 1.f / (S_HID * S_W)};
            pg8::gemm_phase<pg8::EpiYE, pg8::MoEOrder, PG8_ALIGN, PG8_SP2, true>(F.lds + RING_OFF, g, S, E);
            if (BOTH(18)) GRID_BAR();
        }
        if (PH_ON(19) && IN(19)) { moe_table(F, tab); final_phase(F, modl, F.in[23], args.out, tab); }
    }
#undef IN
#undef BOTH
#undef GRID_BAR
}

extern "C" void kernel_launch(void* const* d_in, const int* in_sizes, int n_in, void* d_out, int out_size, void* d_ws, size_t ws_size, hipStream_t stream) {
    static int grid = 0;
    if (grid == 0) {
        if (n_in != 24 || out_size != TLAT * D || ws_size < WS_END) { fprintf(stderr, "kernel_launch: unexpected shapes / workspace (%d inputs, out %d, ws %zu); nothing launched\n", n_in, out_size, ws_size); grid = -1; return; }
        int dev = 0, cus = 0, per_cu = 0;
        if (hipGetDevice(&dev) != hipSuccess || hipDeviceGetAttribute(&cus, hipDeviceAttributeMultiprocessorCount, dev) != hipSuccess) { grid = -1; return; }
        if (hipFuncSetAttribute((const void*)fwd, hipFuncAttributeMaxDynamicSharedMemorySize, LDS_BYTES) != hipSuccess) { fprintf(stderr, "kernel_launch: hipFuncSetAttribute failed\n"); grid = -1; return; }
        if (hipOccupancyMaxActiveBlocksPerMultiprocessor(&per_cu, (const void*)fwd, NWAVES * 64, LDS_BYTES) != hipSuccess || per_cu < 1) fprintf(stderr, "kernel_launch: occupancy query reports %d\n", per_cu);
        (void)hipGetLastError();
        grid = cus;
    }
    if (grid < 0) return;
    if (hipMemsetAsync((char*)d_ws + WS_CTL, 0, CTL_ZERO_BYTES, stream) != hipSuccess) return;
    Args a{};
    for (int i = 0; i < 24; ++i) a.in[i] = (const float*)d_in[i];
    a.out = (float*)d_out; a.ws = (unsigned char*)d_ws;
    if (N_LAUNCHES == 1) { a.ph_lo = 0; a.ph_hi = NPHASE + 1; hipLaunchKernelGGL(fwd, dim3(grid), dim3(NWAVES * 64), LDS_BYTES, stream, a); }
    else for (int p = 0; p <= NPHASE; ++p) { if (p == 9) continue; a.ph_lo = p; a.ph_hi = p + 1;
        const int reps = 1 + ((((unsigned)(REPEAT_MASK)) >> p) & 1u) * REPEAT_EXTRA;
        for (int r = 0; r < reps; ++r) hipLaunchKernelGGL(fwd, dim3(grid), dim3(NWAVES * 64), LDS_BYTES, stream, a); }
}
```

```cpp
#include <hip/hip_runtime.h>
#include <cstdio>
#include <cstdint>
#ifndef MK_N_LAUNCHES
#define MK_N_LAUNCHES 1
#endif
namespace pg8 {
#define PG8_LAS __attribute__((address_space(3)))
typedef unsigned short bf16_t;
typedef short bf16x8 __attribute__((ext_vector_type(8)));
typedef float f32x4 __attribute__((ext_vector_type(4)));
typedef unsigned u32x4 __attribute__((ext_vector_type(4)));
typedef int i32x4 __attribute__((ext_vector_type(4)));
typedef int i32x8 __attribute__((ext_vector_type(8)));
constexpr int BM = 256, BK = 64, HALF = 128, HTB = HALF * BK * 2  , STAGE_BYTES = 8 * HTB, NXCD = 8, WGM = 8;

__host__ __device__ __forceinline__ int lds_byte(int r, int c) { const int st = (r >> 4) * 2 + (c >> 5), rr = r & 15, cc = c & 31, ob = rr * 64 + cc * 2; return st * 1024 + (ob ^ (((ob >> 9) & 1) << 5)); }
__host__ __device__ __forceinline__ void stage_rc(int b, int& R, int& C) { const int st = b / 1024, sb = b % 1024, swz = sb ^ (((sb >> 9) & 1) << 5); R = (st >> 1) * 16 + swz / 64; C = (st & 1) * 32 + (swz % 64) / 2; }
__host__ __device__ __forceinline__ int perm32(int rho) { const int n = rho >> 4, i = rho & 15; return 8 * (i >> 2) + 4 * n + (i & 3); }

struct Unit { int pm, pn, pc; };
struct Gemm { const bf16_t* A; const bf16_t* Bt; int M, N, K; size_t kstepB; };

struct StaticOrder {
    int nM, nN, nwg, G, c;
    __host__ __device__ void init(int M, int N, int G_, int c_) { nM = M / BM; nN = N / BM; nwg = nM * nN; G = G_; c = c_; }
    __host__ __device__ bool next(int i, Unit& u) const {
        const long L = (long)i * G + c; if (L >= nwg) return false;
        int wgid = (int)L; { const int q = nwg / NXCD, r = nwg % NXCD, xcd = wgid % NXCD, off = wgid / NXCD; wgid = (xcd < r ? xcd * (q + 1) : r * (q + 1) + (xcd - r) * q) + off; }
        const int nig = WGM * nN, gid = wgid / nig, fm = gid * WGM, gsz = (nM - fm) < WGM ? (nM - fm) : WGM;
        u.pm = fm + ((wgid % nig) % gsz); u.pn = (wgid % nig) / gsz; u.pc = u.pn; return true;
    }
    __device__ __forceinline__ void a_ready(const Unit&) const {}
    __device__ __forceinline__ void done(const Unit&) const {}
};


typedef float f32x2_t __attribute__((ext_vector_type(2))); typedef __bf16 bf16x2_t __attribute__((ext_vector_type(2)));
__device__ __forceinline__ unsigned cvt_pk_bf16(float lo, float hi) { f32x2_t v = {lo, hi}; bf16x2_t b = __builtin_convertvector(v, bf16x2_t); return __builtin_bit_cast(unsigned, b); }
__device__ __forceinline__ float bf_lo(unsigned w) { return __builtin_bit_cast(float, w << 16); }
__device__ __forceinline__ float bf_hi(unsigned w) { return __builtin_bit_cast(float, w & 0xffff0000u); }
__device__ __forceinline__ float fast_sigmoid(float x) { return __builtin_amdgcn_rcpf(1.0f + __builtin_amdgcn_exp2f(-1.4426950408889634f * x)); }

struct EpiProj {
    static constexpr bool PERM = true, AFTER_DRAIN = false;
    bf16_t* P1; float qscale;
    __device__ __forceinline__ void operator()(const f32x4 (&acc)[2][2][4][2], const Unit& u, int wr, int wc, int fr, int fq) const {
        const int row0 = u.pm * BM + wr * 64 + fr, cin = wc * 32 + 8 * fq;
        const float sc = (u.pc < 2) ? qscale : 1.0f;
#pragma unroll
        for (int ai = 0; ai < 2; ++ai)
#pragma unroll
            for (int m = 0; m < 4; ++m) { bf16_t* rowp = P1 + (size_t)(row0 + ai * HALF + m * 16) * 3072 + u.pc * BM + cin;
#pragma unroll
                for (int bj = 0; bj < 2; ++bj) { const f32x4 v0 = acc[ai][bj][m][0] * sc, v1 = acc[ai][bj][m][1] * sc;
                    u32x4 w; w.x = cvt_pk_bf16(v0[0], v0[1]); w.y = cvt_pk_bf16(v0[2], v0[3]); w.z = cvt_pk_bf16(v1[0], v1[1]); w.w = cvt_pk_bf16(v1[2], v1[3]);
                    *(u32x4*)(rowp + bj * HALF) = w; } }
    }
};
struct EpiGate {
    static constexpr bool PERM = true, AFTER_DRAIN = false;
    bf16_t* GT; const float* bgate; float dsc;
    __device__ __forceinline__ void operator()(const f32x4 (&acc)[2][2][4][2], const Unit& u, int wr, int wc, int fr, int fq) const {
        const int row0 = u.pm * BM + wr * 64 + fr, gcol = u.pc * BM + wc * 32 + 8 * fq;
        f32x4 bv[2][2];
#pragma unroll
        for (int bj = 0; bj < 2; ++bj)
#pragma unroll
            for (int n = 0; n < 2; ++n) bv[bj][n] = *(const f32x4*)(bgate + gcol + bj * HALF + 4 * n);
#pragma unroll
        for (int ai = 0; ai < 2; ++ai)
#pragma unroll
            for (int m = 0; m < 4; ++m) { bf16_t* rowp = GT + (size_t)(row0 + ai * HALF + m * 16) * 2048 + gcol;
#pragma unroll
                for (int bj = 0; bj < 2; ++bj) { const f32x4 v0 = acc[ai][bj][m][0] * dsc + bv[bj][0], v1 = acc[ai][bj][m][1] * dsc + bv[bj][1];
                    u32x4 w; w.x = cvt_pk_bf16(fast_sigmoid(v0[0]), fast_sigmoid(v0[1])); w.y = cvt_pk_bf16(fast_sigmoid(v0[2]), fast_sigmoid(v0[3]));
                    w.z = cvt_pk_bf16(fast_sigmoid(v1[0]), fast_sigmoid(v1[1])); w.w = cvt_pk_bf16(fast_sigmoid(v1[2]), fast_sigmoid(v1[3]));
                    *(u32x4*)(rowp + bj * HALF) = w; } }
    }
};

template <bool SECOND> struct EpiMerge {
    static constexpr bool PERM = true, AFTER_DRAIN = false;
    bf16_t* MG; const bf16_t* GT; int gofs;
    __device__ __forceinline__ void operator()(const f32x4 (&acc)[2][2][4][2], const Unit& u, int wr, int wc, int fr, int fq) const {
        const int row0 = u.pm * BM + wr * 64 + fr, col0 = u.pc * BM + wc * 32 + 8 * fq;
#pragma unroll
        for (int ai = 0; ai < 2; ++ai)
#pragma unroll
            for (int m = 0; m < 4; ++m) { const size_t row = (size_t)(row0 + ai * HALF + m * 16);
#pragma unroll
                for (int bj = 0; bj < 2; ++bj) {
                    const u32x4 g = *(const u32x4*)(GT + row * 2048 + gofs + col0 + bj * HALF);
                    const f32x4 a0 = acc[ai][bj][m][0], a1 = acc[ai][bj][m][1];
                    float o[8] = {bf_lo(g.x) * a0[0], bf_hi(g.x) * a0[1], bf_lo(g.y) * a0[2], bf_hi(g.y) * a0[3], bf_lo(g.z) * a1[0], bf_hi(g.z) * a1[1], bf_lo(g.w) * a1[2], bf_hi(g.w) * a1[3]};
                    bf16_t* dst = MG + row * 1024 + col0 + bj * HALF;
                    if (SECOND) { const u32x4 p = *(const u32x4*)dst;
                        o[0] += bf_lo(p.x); o[1] += bf_hi(p.x); o[2] += bf_lo(p.y); o[3] += bf_hi(p.y); o[4] += bf_lo(p.z); o[5] += bf_hi(p.z); o[6] += bf_lo(p.w); o[7] += bf_hi(p.w); }
                    u32x4 w; w.x = cvt_pk_bf16(o[0], o[1]); w.y = cvt_pk_bf16(o[2], o[3]); w.z = cvt_pk_bf16(o[4], o[5]); w.w = cvt_pk_bf16(o[6], o[7]);
                    *(u32x4*)dst = w; } }
    }
};

struct EpiResid {
    static constexpr bool PERM = false, AFTER_DRAIN = false;
    const float* base_lat; const float* base_ctx; float* out; const float* mod;
    __device__ __forceinline__ void operator()(const f32x4 (&acc)[2][2][4][2], const Unit& u, int wr, int wc, int fr, int fq) const {
        const int col0 = u.pc * BM + wc * 32 + 4 * fq;
        const float* gv = mod + (size_t)(u.pm < 64 ? (u.pm >> 3) : 8) * 6144 + col0;
        const float* base = (u.pm < 64 ? base_lat + (size_t)u.pm * BM * 1024 : base_ctx + (size_t)(u.pm - 64) * BM * 1024) + col0;
        float* o = out + (size_t)u.pm * BM * 1024 + col0;
        f32x4 g4[2][2];
#pragma unroll
        for (int bj = 0; bj < 2; ++bj)
#pragma unroll
            for (int n = 0; n < 2; ++n) g4[bj][n] = *(const f32x4*)(gv + bj * HALF + n * 16);
#pragma unroll
        for (int ai = 0; ai < 2; ++ai)
#pragma unroll
            for (int m = 0; m < 4; ++m) { const size_t off = (size_t)(ai * HALF + wr * 64 + m * 16 + fr) * 1024;
#pragma unroll
                for (int bj = 0; bj < 2; ++bj)
#pragma unroll
                    for (int n = 0; n < 2; ++n) { const f32x4 bs = *(const f32x4*)(base + off + bj * HALF + n * 16);
                        *(f32x4*)(o + off + bj * HALF + n * 16) = bs + g4[bj][n] * acc[ai][bj][m][n]; }
                if (m & 1) asm volatile("" ::: "memory"); }
    }
};

struct EpiSwiGLU {
    static constexpr bool PERM = true, AFTER_DRAIN = false;
    bf16_t* HID;
    __device__ __forceinline__ void operator()(const f32x4 (&acc)[2][2][4][2], const Unit& u, int wr, int wc, int fr, int fq) const {
        const int row0 = u.pm * BM + wr * 64 + fr, col0 = u.pc * HALF + wc * 32 + 8 * fq;
#pragma unroll
        for (int ai = 0; ai < 2; ++ai)
#pragma unroll
            for (int m = 0; m < 4; ++m) { float o[8];
#pragma unroll
                for (int n = 0; n < 2; ++n)
#pragma unroll
                    for (int j = 0; j < 4; ++j) { const float gte = acc[ai][0][m][n][j], up = acc[ai][1][m][n][j]; o[4 * n + j] = gte * fast_sigmoid(gte) * up; }
                u32x4 w; w.x = cvt_pk_bf16(o[0], o[1]); w.y = cvt_pk_bf16(o[2], o[3]); w.z = cvt_pk_bf16(o[4], o[5]); w.w = cvt_pk_bf16(o[6], o[7]);
                *(u32x4*)(HID + (size_t)(row0 + ai * HALF + m * 16) * 2816 + col0) = w; }
    }
};

struct EpiYE {
    static constexpr bool PERM = true, AFTER_DRAIN = false;
    bf16_t* YE; float sc;
    __device__ __forceinline__ void operator()(const f32x4 (&acc)[2][2][4][2], const Unit& u, int wr, int wc, int fr, int fq) const {
        const int row0 = u.pm * BM + wr * 64 + fr, col0 = u.pc * BM + wc * 32 + 8 * fq;
#pragma unroll
        for (int ai = 0; ai < 2; ++ai)
#pragma unroll
            for (int m = 0; m < 4; ++m) { bf16_t* rowp = YE + (size_t)(row0 + ai * HALF + m * 16) * 1024 + col0;
#pragma unroll
                for (int bj = 0; bj < 2; ++bj) { const f32x4 v0 = acc[ai][bj][m][0] * sc, v1 = acc[ai][bj][m][1] * sc;
                    u32x4 w; w.x = cvt_pk_bf16(v0[0], v0[1]); w.y = cvt_pk_bf16(v0[2], v0[3]); w.z = cvt_pk_bf16(v1[0], v1[1]); w.w = cvt_pk_bf16(v1[2], v1[3]);
                    *(u32x4*)(rowp + bj * HALF) = w; } }
    }
};
__device__ __forceinline__ float sat448(float v) { return __builtin_fminf(__builtin_fmaxf(v, -448.0f), 448.0f); }
__device__ __forceinline__ unsigned cvt4_fp8(float a, float b, float c, float d) {
    int w = __builtin_amdgcn_cvt_pk_fp8_f32(sat448(a), sat448(b), 0, false); w = __builtin_amdgcn_cvt_pk_fp8_f32(sat448(c), sat448(d), w, true); return (unsigned)w; }
struct EpiSwiGLU8 {
    static constexpr bool PERM = true, AFTER_DRAIN = false;
    unsigned char* HID; float si, so;
    __device__ __forceinline__ void operator()(const f32x4 (&acc)[2][2][4][2], const Unit& u, int wr, int wc, int fr, int fq) const {
        const int row0 = u.pm * BM + wr * 64 + fr, col0 = u.pc * HALF + wc * 32 + 8 * fq;
#pragma unroll
        for (int ai = 0; ai < 2; ++ai)
#pragma unroll
            for (int m = 0; m < 4; ++m) { float o[8];
#pragma unroll
                for (int n = 0; n < 2; ++n)
#pragma unroll
                    for (int j = 0; j < 4; ++j) { const float gte = acc[ai][0][m][n][j] * si, up = acc[ai][1][m][n][j] * si; o[4 * n + j] = gte * fast_sigmoid(gte) * up * so; }
                typedef unsigned u32x2 __attribute__((ext_vector_type(2)));
                u32x2 w; w.x = cvt4_fp8(o[0], o[1], o[2], o[3]); w.y = cvt4_fp8(o[4], o[5], o[6], o[7]);
                *(u32x2*)(HID + (size_t)(row0 + ai * HALF + m * 16) * 2816 + col0) = w; }
    }
};

struct ProjL1Order {
    StaticOrder S0; int G, c;
    __host__ __device__ void init(int G_, int c_) { S0.init(16384, 3072, G_, c_); G = G_; c = c_; }
    __host__ __device__ bool next(int i, Unit& u) const {
        const long L = (long)i * G + c; if (L < S0.nwg) return S0.next(i, u);
        const int r = (int)(L - S0.nwg); if (r >= 32) return false;
        u.pm = 64 + (r & 7); u.pn = 2 + (r >> 3); u.pc = u.pn; return true;
    }
    __device__ __forceinline__ void a_ready(const Unit&) const {}
    __device__ __forceinline__ void done(const Unit&) const {}
};
struct MoEOrder {
    const PG8_LAS int* tab; int NT, G, c;
    __device__ __forceinline__ bool next(int i, Unit& u) const {
        const int L = i * G + c; if (L >= tab[8] * NT) return false;
        int e = 0;
#pragma unroll
        for (int k = 1; k < 8; ++k) e += (L >= tab[k] * NT) ? 1 : 0;
        const int t0 = tab[e], nte = tab[e + 1] - t0, loc = L - t0 * NT;
        const int ct = loc / nte, rt = loc - ct * nte;
        u.pm = t0 + rt; u.pn = e * NT + ct; u.pc = ct; return true;
    }
    __device__ __forceinline__ void a_ready(const Unit&) const {}
    __device__ __forceinline__ void done(const Unit&) const {}
};
template <class Epi, class Sched, bool ALIGN_EPI = false, bool SP2 = false, bool FP8 = false>
__device__ __forceinline__ void gemm_phase(PG8_LAS unsigned char* lds, const Gemm g, const Sched& S, const Epi& E) {
    const int tid = threadIdx.x, wid = __builtin_amdgcn_readfirstlane(tid >> 6), lane = tid & 63, wr = wid >> 2, wc = wid & 3, fr = lane & 15, fq = lane >> 4;
    const int K = g.K, nt = K / BK;
    unsigned voffA[2], voffB[2];
#pragma unroll
    for (int i = 0; i < 2; ++i) { int R, C; stage_rc(tid * 16 + i * 8192, R, C); const int Rb = Epi::PERM ? ((R & ~31) + perm32(R & 31)) : R;
        voffA[i] = (unsigned)(R * K + C) * 2u; voffB[i] = (unsigned)(Rb * BK + C) * 2u; }
    const size_t kstep = (size_t)(BK * 2);
    const size_t hstep = (size_t)HALF * K * 2;
    const size_t tstep = 2 * hstep;
    const size_t kstepB = g.kstepB, hstepB = (size_t)HALF * BK * 2, tstepB = 2 * hstepB;
    const unsigned ldsw = (unsigned)wid * 1024u;
    const int aoff = lds_byte(wr * 64 + fr, fq * 8), boff = lds_byte(wc * 32 + fr, fq * 8);
#define PG8_SA(b, h) (((b) * 2 + (h)) * HTB)
#define PG8_SB(b, h) ((4 + (b) * 2 + (h)) * HTB)
#define PG8_STAGE(bufoff, gbase, voff) do { _Pragma("unroll") for (int _i = 0; _i < 2; ++_i) \
        __builtin_amdgcn_global_load_lds((const unsigned*)((const char*)(gbase) + (voff)[_i]), (PG8_LAS unsigned*)(lds + (bufoff) + ldsw + _i * 8192), 16, 0, 0); } while (0)
#define PG8_LDA(dst, b, h) do { _Pragma("unroll") for (int m = 0; m < 4; ++m) { if constexpr (FP8) { const i32x4 lo_ = *(const PG8_LAS i32x4*)(lds + PG8_SA(b, h) + aoff + m * 2048), hi_ = *(const PG8_LAS i32x4*)(lds + PG8_SA(b, h) + aoff + m * 2048 + 1024); \
        dst##8[m] = __builtin_shufflevector(lo_, hi_, 0, 1, 2, 3, 4, 5, 6, 7); } else { _Pragma("unroll") for (int k = 0; k < 2; ++k) dst[m][k] = *(const PG8_LAS bf16x8*)(lds + PG8_SA(b, h) + aoff + m * 2048 + k * 1024); } } } while (0)
#define PG8_LDB(dst, b, h) do { _Pragma("unroll") for (int n = 0; n < 2; ++n) { if constexpr (FP8) { const i32x4 lo_ = *(const PG8_LAS i32x4*)(lds + PG8_SB(b, h) + boff + n * 2048), hi_ = *(const PG8_LAS i32x4*)(lds + PG8_SB(b, h) + boff + n * 2048 + 1024); \
        dst##8[n] = __builtin_shufflevector(lo_, hi_, 0, 1, 2, 3, 4, 5, 6, 7); } else { _Pragma("unroll") for (int k = 0; k < 2; ++k) dst[n][k] = *(const PG8_LAS bf16x8*)(lds + PG8_SB(b, h) + boff + n * 2048 + k * 1024); } } } while (0)
#define PG8_MMA(ai, bj, At, Bt) do { __builtin_amdgcn_s_setprio(1); _Pragma("unroll") for (int m = 0; m < 4; ++m) _Pragma("unroll") for (int n = 0; n < 2; ++n) { \
        if constexpr (FP8) {   \
            asm volatile("v_mfma_f32_16x16x128_f8f6f4 %0, %1, %2, %0" : "+v"(acc[ai][bj][m][n]) : "v"(Bt##8[n]), "v"(At##8[m]));   \
        } else { _Pragma("unroll") for (int k = 0; k < 2; ++k) acc[ai][bj][m][n] = __builtin_amdgcn_mfma_f32_16x16x32_bf16(Bt[n][k], At[m][k], acc[ai][bj][m][n], 0, 0, 0); } } \
        __builtin_amdgcn_s_setprio(0); } while (0)
#define PG8_WAIT_V(n) asm volatile("s_waitcnt vmcnt(" #n ")" ::: "memory")
#define PG8_WAIT_L(n) asm volatile("s_waitcnt lgkmcnt(" #n ")" ::: "memory")
#define PG8_BAR __builtin_amdgcn_s_barrier()
#define PG8_SCHED __builtin_amdgcn_sched_barrier(0)
    Unit cur, nxt; int ui = 0;
    if (!S.next(0, cur)) return;
    f32x4 acc[2][2][4][2];
#pragma unroll
    for (int a = 0; a < 2; ++a)
#pragma unroll
        for (int b = 0; b < 2; ++b)
#pragma unroll
            for (int m = 0; m < 4; ++m)
#pragma unroll
                for (int n = 0; n < 2; ++n) acc[a][b][m][n] = (f32x4){0.f, 0.f, 0.f, 0.f};
    bf16x8 At[4][2], B0[2][2], B1[2][2]; i32x8 At8[4], B08[2], B18[2];
    const char* cA = (const char*)g.A + (size_t)cur.pm * tstep; const char* cB = (const char*)g.Bt + (size_t)cur.pn * tstepB;
    S.a_ready(cur);
    if constexpr (SP2) {
        PG8_STAGE(PG8_SB(0, 0), cB, voffB); PG8_STAGE(PG8_SB(0, 1), cB + hstepB, voffB); PG8_STAGE(PG8_SA(0, 0), cA, voffA); PG8_STAGE(PG8_SA(0, 1), cA + hstep, voffA);
        if (wr == 1) PG8_BAR;
        PG8_WAIT_V(2); PG8_BAR;
        PG8_STAGE(PG8_SB(1, 0), cB + kstepB, voffB); PG8_STAGE(PG8_SA(1, 0), cA + kstep, voffA); PG8_STAGE(PG8_SB(1, 1), cB + hstepB + kstepB, voffB);
        PG8_WAIT_V(6); PG8_BAR;
    } else {
        PG8_STAGE(PG8_SB(0, 0), cB, voffB); PG8_STAGE(PG8_SA(0, 0), cA, voffA); PG8_STAGE(PG8_SB(0, 1), cB + hstepB, voffB); PG8_STAGE(PG8_SA(0, 1), cA + hstep, voffA);
        if (wr == 1) PG8_BAR;
        PG8_WAIT_V(4); PG8_BAR;
        PG8_STAGE(PG8_SB(1, 0), cB + kstepB, voffB); PG8_STAGE(PG8_SA(1, 0), cA + kstep, voffA); PG8_STAGE(PG8_SB(1, 1), cB + hstepB + kstepB, voffB);
        PG8_WAIT_V(6); PG8_BAR;
    }
    for (;;) {
        const bool has_next = S.next(ui + 1, nxt);
        const char* nA = has_next ? (const char*)g.A + (size_t)nxt.pm * tstep : cA; const char* nB = has_next ? (const char*)g.Bt + (size_t)nxt.pn * tstepB : cB;
        for (int t = 0; t < nt; t += 2) {
            const bool last = (t == nt - 2);
            const char* a1 = cA + (size_t)(t + 1) * kstep;
            const char* a2 = last ? nA : cA + (size_t)(t + 2) * kstep; const char* b2 = last ? nB : cB + (size_t)(t + 2) * kstepB;
            const char* a3 = a2 + kstep; const char* b3 = b2 + kstepB;
            if (last && has_next) S.a_ready(nxt);
            if constexpr (SP2) {
            PG8_LDB(B0, 0, 0); PG8_LDB(B1, 0, 1); PG8_SCHED; PG8_LDA(At, 0, 0); PG8_STAGE(PG8_SA(1, 1), a1 + hstep, voffA);
            PG8_WAIT_V(8); PG8_WAIT_L(0); PG8_BAR; PG8_MMA(0, 0, At, B0); PG8_MMA(0, 1, At, B1); PG8_BAR; PG8_SCHED;
            PG8_LDA(At, 0, 1); PG8_STAGE(PG8_SB(0, 0), b2, voffB); PG8_STAGE(PG8_SB(0, 1), b2 + hstepB, voffB); PG8_STAGE(PG8_SA(0, 0), a2, voffA);
            PG8_WAIT_V(8); PG8_WAIT_L(0); PG8_BAR; PG8_MMA(1, 0, At, B0); PG8_MMA(1, 1, At, B1); PG8_BAR; PG8_SCHED;
            PG8_LDB(B0, 1, 0); PG8_LDB(B1, 1, 1); PG8_SCHED; PG8_LDA(At, 1, 0); PG8_STAGE(PG8_SA(0, 1), a2 + hstep, voffA);
            PG8_WAIT_V(8); PG8_WAIT_L(0); PG8_BAR; PG8_MMA(0, 0, At, B0); PG8_MMA(0, 1, At, B1); PG8_BAR; PG8_SCHED;
            PG8_LDA(At, 1, 1); PG8_STAGE(PG8_SB(1, 0), b3, voffB); PG8_STAGE(PG8_SB(1, 1), b3 + hstepB, voffB); PG8_STAGE(PG8_SA(1, 0), a3, voffA);
            PG8_WAIT_V(8); PG8_WAIT_L(0); PG8_BAR; PG8_MMA(1, 0, At, B0); PG8_MMA(1, 1, At, B1); PG8_BAR; PG8_SCHED;
            } else {
            PG8_LDB(B0, 0, 0); PG8_SCHED; PG8_LDA(At, 0, 0); PG8_STAGE(PG8_SA(1, 1), a1 + hstep, voffA);
            PG8_WAIT_L(8); PG8_BAR; PG8_WAIT_L(0); PG8_MMA(0, 0, At, B0); PG8_BAR; PG8_SCHED;
            PG8_LDB(B1, 0, 1); PG8_STAGE(PG8_SB(0, 0), b2, voffB);
            PG8_BAR; PG8_WAIT_L(0); PG8_MMA(0, 1, At, B1); PG8_BAR;
            PG8_LDA(At, 0, 1); PG8_STAGE(PG8_SA(0, 0), a2, voffA);
            PG8_BAR; PG8_WAIT_L(0); PG8_MMA(1, 0, At, B0); PG8_BAR; PG8_SCHED;
            PG8_STAGE(PG8_SB(0, 1), b2 + hstepB, voffB);
            PG8_WAIT_V(6); PG8_BAR; PG8_MMA(1, 1, At, B1); PG8_BAR;
            PG8_LDB(B0, 1, 0); PG8_SCHED; PG8_LDA(At, 1, 0); PG8_STAGE(PG8_SA(0, 1), a2 + hstep, voffA);
            PG8_WAIT_L(8); PG8_BAR; PG8_WAIT_L(0); PG8_MMA(0, 0, At, B0); PG8_BAR; PG8_SCHED;
            PG8_LDB(B1, 1, 1); PG8_STAGE(PG8_SB(1, 0), b3, voffB);
            PG8_BAR; PG8_WAIT_L(0); PG8_MMA(0, 1, At, B1); PG8_BAR;
            PG8_LDA(At, 1, 1); PG8_STAGE(PG8_SA(1, 0), a3, voffA);
            PG8_BAR; PG8_WAIT_L(0); PG8_MMA(1, 0, At, B0); PG8_BAR; PG8_SCHED;
            PG8_STAGE(PG8_SB(1, 1), b3 + hstepB, voffB);
            PG8_WAIT_V(6); PG8_BAR; PG8_MMA(1, 1, At, B1); PG8_BAR;
            }
        }
        if constexpr (FP8) {
            asm volatile("s_nop 15\n\ts_nop 15\n\ts_nop 7" : "+v"(acc[0][0][0][0]), "+v"(acc[0][0][0][1]), "+v"(acc[0][0][1][0]), "+v"(acc[0][0][1][1]), "+v"(acc[0][0][2][0]), "+v"(acc[0][0][2][1]), "+v"(acc[0][0][3][0]), "+v"(acc[0][0][3][1]));
            asm volatile("" : "+v"(acc[0][1][0][0]), "+v"(acc[0][1][0][1]), "+v"(acc[0][1][1][0]), "+v"(acc[0][1][1][1]), "+v"(acc[0][1][2][0]), "+v"(acc[0][1][2][1]), "+v"(acc[0][1][3][0]), "+v"(acc[0][1][3][1]));
            asm volatile("" : "+v"(acc[1][0][0][0]), "+v"(acc[1][0][0][1]), "+v"(acc[1][0][1][0]), "+v"(acc[1][0][1][1]), "+v"(acc[1][0][2][0]), "+v"(acc[1][0][2][1]), "+v"(acc[1][0][3][0]), "+v"(acc[1][0][3][1]));
            asm volatile("" : "+v"(acc[1][1][0][0]), "+v"(acc[1][1][0][1]), "+v"(acc[1][1][1][0]), "+v"(acc[1][1][1][1]), "+v"(acc[1][1][2][0]), "+v"(acc[1][1][2][1]), "+v"(acc[1][1][3][0]), "+v"(acc[1][1][3][1]));
        }
        if constexpr (ALIGN_EPI) { if (wr == 0) PG8_BAR; }
        if constexpr (!Epi::AFTER_DRAIN) { E(acc, cur, wr, wc, fr, fq); S.done(cur); }
        if (!has_next) break;
#pragma unroll
        for (int a = 0; a < 2; ++a)
#pragma unroll
            for (int b = 0; b < 2; ++b)
#pragma unroll
                for (int m = 0; m < 4; ++m)
#pragma unroll
                    for (int n = 0; n < 2; ++n) acc[a][b][m][n] = (f32x4){0.f, 0.f, 0.f, 0.f};
        cur = nxt; cA = nA; cB = nB; ++ui;
        if constexpr (ALIGN_EPI) { if (wr == 1) PG8_BAR; }
    }
    PG8_WAIT_V(0);
    if constexpr (!ALIGN_EPI) { if (wr == 0) PG8_BAR; }
    PG8_BAR;
    if constexpr (Epi::AFTER_DRAIN) { E.fused(acc, cur, wr, wc, fr, fq, lds, wid, lane); S.done(cur); }
#undef PG8_SA
#undef PG8_SB
#undef PG8_STAGE
#undef PG8_LDA
#undef PG8_LDB
#undef PG8_MMA
#undef PG8_WAIT_V
#undef PG8_WAIT_L
#undef PG8_BAR
#undef PG8_SCHED
}
}

#ifndef PG8_SP2
#define PG8_SP2 true
#endif
#ifndef PG8_ALIGN
#define PG8_ALIGN true
#endif

constexpr int NWAVES = 8;
constexpr int D = 1024, NB = 8, SEQ = 2048, CTXL = 256;
constexpr int TLAT = NB * SEQ, TCTX = NB * CTXL, TALL = TLAT + TCTX;
constexpr int NHEAD = 8, HDIM = 64, AW = 512, CW = 512, PW = 3072, GW = 2048, FF = 2816, NEXP = 8;
constexpr int SLOTS_MAX = 2 * TLAT + NEXP * 256;
constexpr float EPS = 1e-6f, LOG2E = 1.4426950408889634f;
constexpr int NPHASE = 19;
constexpr int N_LAUNCHES = MK_N_LAUNCHES;
static_assert(N_LAUNCHES == 1 || N_LAUNCHES == NPHASE, "MK_N_LAUNCHES is 1 or 19");

constexpr size_t MiB = 1u << 20;
constexpr size_t WS_CTL = 0, CTL_ZERO_BYTES = 1 * MiB;
constexpr size_t WS_MOD = 1 * MiB;
constexpr size_t WS_ROUTE = 2 * MiB;
constexpr size_t WS_X = 4 * MiB;
constexpr size_t WS_RA = 76 * MiB;
constexpr size_t WS_RB = 112 * MiB;
constexpr size_t WS_GT = WS_RB + 108 * MiB;
constexpr size_t WS_YE = WS_RB + 94 * MiB;
constexpr size_t WS_WM0 = 300 * MiB, WS_WM1 = 314 * MiB;
constexpr size_t WS_WD = 328 * MiB;
constexpr size_t WS_WE = 345 * MiB;
constexpr size_t WS_WED = WS_WE + 44 * MiB;
constexpr size_t WS_H8 = 412 * MiB;
constexpr size_t WS_END = 430 * MiB;
constexpr float S_H2 = 16.f, S_W = 256.f, S_HID = 8.f;
#ifndef PB1_FP8
#define PB1_FP8 0
#endif
constexpr size_t WM_G1 = 0, WM_G8 = 6 * MiB, WM_A = 10 * MiB, WM_C = 11 * MiB, WM_O = 12 * MiB;
constexpr size_t WD_GU = 0, WD_DN = 11 * MiB;
constexpr int CW_BAR = 4096;
constexpr int CW_FILL = 16384;

constexpr int RING_OFF = 0, RING_BYTES = 131072;
constexpr int LDSCTL_OFF = RING_BYTES, MISC_OFF = LDSCTL_OFF + 320;
constexpr int LDS_BYTES = 147456;

#define GAS __attribute__((address_space(1)))
#define LAS __attribute__((address_space(3)))
typedef unsigned short bf16;
typedef unsigned v4u __attribute__((ext_vector_type(4)));
typedef unsigned v2u __attribute__((ext_vector_type(2)));
typedef float f32x4 __attribute__((ext_vector_type(4)));
typedef float f32x16 __attribute__((ext_vector_type(16)));
typedef short bf16x8 __attribute__((ext_vector_type(8)));
typedef short s16x4 __attribute__((ext_vector_type(4)));
typedef GAS unsigned gu32;
#define RLX_AGENT __ATOMIC_RELAXED, __HIP_MEMORY_SCOPE_AGENT
#define LDS_WAIT() asm volatile("s_waitcnt lgkmcnt(0)" ::: "memory")
using pg8::cvt_pk_bf16; using pg8::bf_lo; using pg8::bf_hi;

#define XB_TMO      128
#define XB_XCNT(j)  (256  + 64 * (j))
#define XB_XSUB(j)  (1280 + 64 * (j))
#define XB_XGEN(j)  (2304 + 64 * (j))
#define XB_TOP      3328
#define XB_TOPGEN   3392
#define XCD_BAR_WORDS 3456
#define XB_SPIN_CAP (1u << 18)

__device__ __forceinline__ unsigned xb_ld(unsigned* p)              { return __hip_atomic_load(p, __ATOMIC_RELAXED, __HIP_MEMORY_SCOPE_AGENT); }
__device__ __forceinline__ unsigned xb_add(unsigned* p, unsigned v) { return __hip_atomic_fetch_add(p, v, __ATOMIC_RELAXED, __HIP_MEMORY_SCOPE_AGENT); }
__device__ __forceinline__ unsigned xb_xcc_id() { return (unsigned)__builtin_amdgcn_s_getreg((3 << 11) | 20) & 0xFu; }
#define XB_SPIN(cond, bar) do { unsigned _sp = 0; while (cond) { __builtin_amdgcn_s_sleep(1); \
    if ((++_sp & 255u) == 0u) { if (xb_ld(&(bar)[XB_TMO])) break; if (_sp > XB_SPIN_CAP) { atomicAdd(&(bar)[XB_TMO], 1u); break; } } } } while (0)

struct XcdBarrier {
    unsigned* bar; unsigned x;
    volatile LAS unsigned* st;
};

__device__ __forceinline__ XcdBarrier xcd_barrier_post(unsigned* bar, volatile LAS unsigned* st) {
    XcdBarrier b; b.bar = bar; b.x = xb_xcc_id(); b.st = st;
    if (threadIdx.x == 0) (void)xb_add(&bar[XB_XCNT(b.x)], 1u);
    return b;
}
__device__ __forceinline__ void xcd_barrier_complete(unsigned* bar, unsigned x, unsigned& nloc, unsigned& nx) {
    const unsigned G = gridDim.x * gridDim.y * gridDim.z;
    unsigned sum, cnt, mine, sp = 0u;
    for (;;) {
        sum = 0u; cnt = 0u; mine = 0u;
#pragma unroll
        for (unsigned j = 0; j < 16; ++j) { const unsigned c = xb_ld(&bar[XB_XCNT(j)]); sum += c; cnt += (c > 0u) ? 1u : 0u; mine = (j == x) ? c : mine; }
        if (sum == G) break;
        __builtin_amdgcn_s_sleep(1);
        if ((++sp & 255u) == 0u) { if (xb_ld(&bar[XB_TMO])) break; if (sp > XB_SPIN_CAP) { atomicAdd(&bar[XB_TMO], 1u); break; } }
    }
    nloc = mine > 0u ? mine : 1u; nx = cnt > 0u ? cnt : 1u;
}

__device__ __forceinline__ void xcd_barrier(const XcdBarrier& b) {
    asm volatile("s_waitcnt vmcnt(0)" ::: "memory");
    __syncthreads();
    if (threadIdx.x == 0) {
        unsigned* bar = b.bar;
        __builtin_amdgcn_s_waitcnt(0);
        unsigned nloc = b.st[0], nx = b.st[1];
        if (nloc == 0u) { xcd_barrier_complete(bar, b.x, nloc, nx); b.st[0] = nloc; b.st[1] = nx; }
        const unsigned old = xb_add(&bar[XB_XSUB(b.x)], 1u);
        const unsigned gen = old / nloc;
        if (old + 1u == (gen + 1u) * nloc) {
            __builtin_amdgcn_fence(__ATOMIC_RELEASE, "agent");
            asm volatile("s_waitcnt vmcnt(0)" ::: "memory");
            const unsigned og = xb_add(&bar[XB_TOP], 1u);
            const unsigned tg = og / nx;
            if (og + 1u == (tg + 1u) * nx) xb_add(&bar[XB_TOPGEN], 1u);
            else XB_SPIN(xb_ld(&bar[XB_TOPGEN]) == tg, bar);
            __builtin_amdgcn_fence(__ATOMIC_ACQUIRE, "agent");
            xb_add(&bar[XB_XGEN(b.x)], 1u);
            asm volatile("s_waitcnt vmcnt(0)" ::: "memory");
        } else {
            XB_SPIN(xb_ld(&bar[XB_XGEN(b.x)]) == gen, bar);
            __builtin_amdgcn_fence(__ATOMIC_ACQUIRE, "agent");
            asm volatile("s_waitcnt vmcnt(0)" ::: "memory");
        }
    }
    __syncthreads();
}


struct Frame {
    LAS unsigned char* lds;
    volatile LAS unsigned* MISC;
    unsigned* ctl;
    unsigned char* ws;
    int tid, lane, wave, G;
    const float* const* in;
};

__device__ __forceinline__ float wave_sum(float v) {
#pragma unroll
    for (int o = 1; o < 64; o <<= 1) v += __shfl_xor(v, o);
    return v;
}
__device__ __forceinline__ float silu_f(float v) { return v / (1.f + __expf(-v)); }

template <bool FP8>
__device__ __forceinline__ void convert_item(const float* W, int K, int N, unsigned char* WT, int rows_total, int row_off, int mode, float scale, LAS unsigned char* scr, int item, int lane) {
    constexpr int KT = FP8 ? 128 : 64;
    const int nblk = N / 64, kt = item / nblk, nb = item - kt * nblk, n0 = 64 * nb;
    const int drow0 = row_off + (mode == 0 ? n0 : ((n0 >> 7) << 8) + (n0 & 127) + (mode == 2 ? 128 : 0));
    const GAS float* src = (const GAS float*)(W + (size_t)(kt * KT) * N + n0) + lane;
    float v[KT];
#pragma unroll
    for (int i = 0; i < KT; ++i) v[i] = src[(size_t)i * N];
    LAS v4u* wrow = (LAS v4u*)(scr + lane * 144);
#pragma unroll
    for (int q = 0; q < 8; ++q) { v4u o;
#pragma unroll
        for (int w = 0; w < 4; ++w) {
            if (FP8) o[w] = pg8::cvt4_fp8(v[16 * q + 4 * w] * scale, v[16 * q + 4 * w + 1] * scale, v[16 * q + 4 * w + 2] * scale, v[16 * q + 4 * w + 3] * scale);
            else o[w] = cvt_pk_bf16(v[(8 * q + 2 * w) % KT], v[(8 * q + 2 * w + 1) % KT]); }
        wrow[q] = o; }
    asm volatile("s_waitcnt lgkmcnt(0)" ::: "memory");
    GAS v4u* dst = (GAS v4u*)(WT + (size_t)kt * rows_total * 128 + (size_t)drow0 * 128) + lane;
    const LAS unsigned char* rrow = scr + (lane >> 3) * 144 + (lane & 7) * 16;
#pragma unroll
    for (int i = 0; i < 8; ++i) dst[64 * i] = *(const LAS v4u*)(rrow + i * 8 * 144);
    asm volatile("s_waitcnt lgkmcnt(0)" ::: "memory");
}

constexpr int I_IN = (1024 / 64) * (3072 / 64), I_GT = (1024 / 128) * (2048 / 64), I_AO = (512 / 64) * (1024 / 64), I_O = (1024 / 64) * (1024 / 64);
constexpr int I_MIX = I_IN + I_GT + 2 * I_AO + I_O;
constexpr int I_FG = (1024 / 64) * (2816 / 64), I_FD = (2816 / 64) * (1024 / 64), I_E = 2 * I_FG + I_FD;
constexpr int I_XG = (1024 / 128) * (2816 / 64), I_XD = (2816 / 128) * (1024 / 64), I_X = 2 * I_XG + I_XD;
constexpr int NDEF = I_E + I_MIX + NEXP * I_X;
__device__ __forceinline__ void mixer_item(Frame& F, int l, int r, LAS unsigned char* scr) {
    unsigned char* wm = F.ws + (l == 0 ? WS_WM0 : WS_WM1);
    if (r < I_IN) { convert_item<false>(F.in[8] + (size_t)l * 1024 * 3072, 1024, 3072, wm + WM_G1, 3072, 0, 0, 1.f, scr, r, F.lane); return; } r -= I_IN;
    if (r < I_GT) { convert_item<true>(F.in[13] + (size_t)l * 1024 * 2048, 1024, 2048, wm + WM_G8, 2048, 0, 0, S_W, scr, r, F.lane); return; } r -= I_GT;
    if (r < I_AO) { convert_item<false>(F.in[11] + (size_t)l * 512 * 1024, 512, 1024, wm + WM_A, 1024, 0, 0, 1.f, scr, r, F.lane); return; } r -= I_AO;
    if (r < I_AO) { convert_item<false>(F.in[12] + (size_t)l * 512 * 1024, 512, 1024, wm + WM_C, 1024, 0, 0, 1.f, scr, r, F.lane); return; } r -= I_AO;
    convert_item<false>(F.in[15] + (size_t)l * 1024 * 1024, 1024, 1024, wm + WM_O, 1024, 0, 0, 1.f, scr, r, F.lane);
}
__device__ __forceinline__ void deferred_item(Frame& F, int r, LAS unsigned char* scr) {
    if (r < I_E) {
        if (r < I_FG) { convert_item<false>(F.in[16], 1024, 2816, F.ws + WS_WD + WD_GU, 5632, 0, 1, 1.f, scr, r, F.lane); return; } r -= I_FG;
        if (r < I_FG) { convert_item<false>(F.in[17], 1024, 2816, F.ws + WS_WD + WD_GU, 5632, 0, 2, 1.f, scr, r, F.lane); return; } r -= I_FG;
        convert_item<false>(F.in[18], 2816, 1024, F.ws + WS_WD + WD_DN, 1024, 0, 0, 1.f, scr, r, F.lane); return;
    }
    r -= I_E;
    if (r < I_MIX) { mixer_item(F, 1, r, scr); return; }
    r -= I_MIX;
    const int e = r / I_X; r -= e * I_X;
    if (r < I_XG) { convert_item<true>(F.in[20] + (size_t)e * 1024 * 2816, 1024, 2816, F.ws + WS_WE, NEXP * 5632, e * 5632, 1, S_W, scr, r, F.lane); return; } r -= I_XG;
    if (r < I_XG) { convert_item<true>(F.in[21] + (size_t)e * 1024 * 2816, 1024, 2816, F.ws + WS_WE, NEXP * 5632, e * 5632, 2, S_W, scr, r, F.lane); return; } r -= I_XG;
    convert_item<true>(F.in[22] + (size_t)e * 2816 * 1024, 2816, 1024, F.ws + WS_WED, NEXP * 1024, e * 1024, 0, S_W, scr, r, F.lane);
}
__device__ __forceinline__ void filler(Frame& F, int nwg, int lo, int hi) {
    const int rem = nwg % F.G, c = (int)blockIdx.x;
    if (c < rem) return;
    LAS unsigned char* scr = F.lds + RING_OFF + F.wave * 9216;
    for (int it = lo + (c - rem) * NWAVES + F.wave; it < hi; it += (F.G - rem) * NWAVES) deferred_item(F, it, scr);
    __syncthreads();
}
__device__ __forceinline__ void filler_part(Frame& F, bool part, int p, int n_part, int lo, int hi) {
    if (!part) return;
    LAS unsigned char* scr = F.lds + RING_OFF + F.wave * 9216;
    for (int it = lo + p * NWAVES + F.wave; it < hi; it += n_part * NWAVES) deferred_item(F, it, scr);
    __syncthreads();
}
constexpr int DW_P0 = 0, DW_PB0 = 1400, DW_PD0A = 2600, DW_PD0B = 3796, DW_PE0 = 4596, DW_PG0 = 5996, DW_PH0 = 7296, DW_PB1 = 10696, DW_END = NDEF;
static_assert(DW_PG0 >= I_E && DW_PB1 >= I_E + I_MIX && DW_PB1 < NDEF, "deferred windows: dense FFN weights before PG0, layer-1 mixer weights before PB1");

__device__ __forceinline__ void p0_prologue(Frame& F) {
    const float* c = F.in[1]; const float* cctx = F.in[3]; const float* w_ada = F.in[4]; const float* b_ada = F.in[5];
    float* MOD = (float*)(F.ws + WS_MOD);
    LAS float* sl = (LAS float*)(F.lds);
    LAS float* red = (LAS float*)(F.lds + 9 * 1024 * 4);
    bool have_sl = false;
    for (int it = blockIdx.x; it < 2 * 128; it += F.G) {
        if (!have_sl) { for (int i = F.tid; i < 9 * 1024; i += NWAVES * 64) { const int j = i >> 10, k = i & 1023; sl[i] = silu_f(j < 8 ? c[j * 1024 + k] : cctx[k]); } have_sl = true; }
        __syncthreads();
        const int l = it >> 7, col0 = (it & 127) * 48, cl_ = F.lane < 48 ? F.lane : 47;
        const float* wp = w_ada + (size_t)l * 1024 * 6144 + (size_t)(F.wave * 128) * 6144 + col0 + cl_;
        float a[9];
#pragma unroll
        for (int j = 0; j < 9; ++j) a[j] = 0.f;
#pragma unroll 1
        for (int k0 = 0; k0 < 128; k0 += 32) { float wv[32];
#pragma unroll
            for (int k = 0; k < 32; ++k) wv[k] = wp[(size_t)(k0 + k) * 6144];
#pragma unroll
            for (int k = 0; k < 32; ++k)
#pragma unroll
                for (int j = 0; j < 9; ++j) a[j] += sl[j * 1024 + F.wave * 128 + k0 + k] * wv[k]; }
#pragma unroll
        for (int j = 0; j < 9; ++j) red[(F.wave * 9 + j) * 64 + F.lane] = a[j];
        __syncthreads();
        for (int i = F.tid; i < 9 * 64; i += NWAVES * 64) { const int j = i >> 6, cl = i & 63; if (cl < 48) { float s = 0.f;
#pragma unroll
            for (int w = 0; w < 8; ++w) s += red[(w * 9 + j) * 64 + cl];
            MOD[(size_t)(l * 9 + j) * 6144 + col0 + cl] = s + b_ada[l * 6144 + col0 + cl]; } }
    }
    const int gw = blockIdx.x * NWAVES + F.wave, NGW = F.G * NWAVES;
    __syncthreads();
    LAS unsigned char* scr = F.lds + RING_OFF + F.wave * 9216;
    for (int it = gw; it < I_MIX + DW_PB0; it += NGW) { if (it < I_MIX) mixer_item(F, 0, it, scr); else deferred_item(F, it - I_MIX, scr); }
#ifdef EXP_PH0_IN_P0
    for (int it = DW_PH0 + gw; it < DW_PB1; it += NGW) deferred_item(F, it, scr);
#endif
}

struct RowVec { f32x4 v[4]; };
__device__ __forceinline__ void row_load(RowVec& r, const float* p, int lane) {
    const GAS f32x4* q = (const GAS f32x4*)p + lane;
#pragma unroll
    for (int j = 0; j < 4; ++j) r.v[j] = q[64 * j];
}
__device__ __forceinline__ float row_rms_scale(const RowVec& x) {
    float s = 0.f;
#pragma unroll
    for (int j = 0; j < 4; ++j) s += (x.v[j].x * x.v[j].x + x.v[j].y * x.v[j].y) + (x.v[j].z * x.v[j].z + x.v[j].w * x.v[j].w);
    return rsqrtf(wave_sum(s) * (1.f / D) + EPS);
}
__device__ __forceinline__ void row_store_bf16(const RowVec& r, bf16* p, int lane) {
    GAS v2u* o = (GAS v2u*)p + lane;
#pragma unroll
    for (int j = 0; j < 4; ++j) { v2u w; w.x = cvt_pk_bf16(r.v[j].x, r.v[j].y); w.y = cvt_pk_bf16(r.v[j].z, r.v[j].w); o[64 * j] = w; }
}
__device__ __forceinline__ void row_store_fp8(const RowVec& r, unsigned char* p, int lane, float scale) {
    GAS unsigned* o = (GAS unsigned*)p + lane;
#pragma unroll
    for (int j = 0; j < 4; ++j) o[64 * j] = pg8::cvt4_fp8(r.v[j].x * scale, r.v[j].y * scale, r.v[j].z * scale, r.v[j].w * scale);
}
__device__ __forceinline__ const float* xrow_ptr(Frame& F, bool from_input, int row) {
    if (from_input) return row < TLAT ? F.in[0] + (size_t)row * D : F.in[2] + (size_t)(row - TLAT) * D;
    return (const float*)(F.ws + WS_X) + (size_t)row * D;
}
template <bool FP8OUT = false>
__device__ __forceinline__ void modulate_phase(Frame& F, bool from_input, const float* gain, const float* modl  , int sh_off, int sc_off, bf16* H, int nrows, unsigned char* H8 = nullptr, int nrows8 = 0) {
    const int gw = blockIdx.x * NWAVES + F.wave, NGW = F.G * NWAVES;
    const int per = (nrows + NGW - 1) / NGW;
    RowVec g, sh, sc; row_load(g, gain, F.lane);
    int cur_b = -1;
    for (int i = 0; i < per; ++i) {
        const int row = gw * per + i; if (row >= nrows) break;
        const int b = row < TLAT ? row / SEQ : 8;
        if (b != cur_b) { row_load(sh, modl + (size_t)b * 6144 + sh_off, F.lane); row_load(sc, modl + (size_t)b * 6144 + sc_off, F.lane); cur_b = b; }
        RowVec x; row_load(x, xrow_ptr(F, from_input, row), F.lane);
        const float r = row_rms_scale(x);
#pragma unroll
        for (int j = 0; j < 4; ++j) x.v[j] = x.v[j] * r * g.v[j] * (1.f + sc.v[j]) + sh.v[j];
        if (FP8OUT) row_store_fp8(x, (unsigned char*)H + (size_t)row * D, F.lane, S_H2); else row_store_bf16(x, H + (size_t)row * D, F.lane);
        if (H8 && row < nrows8) row_store_fp8(x, H8 + (size_t)row * D, F.lane, S_H2);
    }
}

namespace att {
constexpr int KP = 144;
constexpr int BLK_B = 64 * KP;
constexpr int OFF_K = 0, OFF_V = 4 * BLK_B, OFF_BIAS = 8 * BLK_B, ATT_LDS = OFF_BIAS + 2048;
__device__ __forceinline__ int pos32(int k) { const int s = k >> 4, k16 = k & 15; return 16 * s + 8 * ((k16 >> 2) & 1) + (((k16 >> 3) << 2) | (k16 & 3)); }
__device__ __forceinline__ int clampi(int v, int lo, int hi) { return v < lo ? lo : (v > hi ? hi : v); }
#define MFMA32(a, b, c) __builtin_amdgcn_mfma_f32_32x32x16_bf16((a), (b), (c), 0, 0, 0)

template <bool CTXQ>
__device__ __forceinline__ void attn_unit(LAS unsigned char* sm, const bf16* __restrict__ P1, bf16* __restrict__ YA, const float* __restrict__ rpb_lh, int b, int h, int r0) {
    const int tid = threadIdx.x, lane = tid & 63, l32 = lane & 31, hi = lane >> 5; const int wid = __builtin_amdgcn_readfirstlane(tid >> 6);
    const int R_lo = CTXQ ? 0 : clampi(r0 - 4, 0, 24);
    const int n_loc = CTXQ ? 0 : (clampi(r0 - 1, 0, 24) + 8 - R_lo);
    const int nb = n_loc + 4, nsteps = (nb + 1) >> 1;
    const int rp = wid >> 2, cb = wid & 3;
    const int qrow = r0 + 2 * rp + (l32 >> 4), qc = 16 * cb + (l32 & 15);
    const int a0 = clampi(16 * cb - 8, 0, 32);
    const int w_lo = clampi(r0 + 2 * rp - 4, 0, 24), w_hi = clampi(r0 + 2 * rp + 1 - 4, 0, 24) + 8;
    const int my_rs = clampi(qrow - 4, 0, 24), cs = clampi(qc - 8, 0, 48);
    const size_t qtok = CTXQ ? (size_t)(TLAT + b * CTXL + wid * 32 + l32) : (size_t)(b * SEQ + qrow * 64 + qc);
    if (!CTXQ) { if (tid < 465) ((LAS float*)(sm + OFF_BIAS))[tid] = rpb_lh[tid] * LOG2E; }
    bf16x8 qr[4];
#pragma unroll
    for (int kk = 0; kk < 4; ++kk) qr[kk] = *(const bf16x8*)(P1 + qtok * PW + h * HDIM + kk * 16 + hi * 8);
    const int skey = tid >> 3, sch = tid & 7;
    const int tq = (lane & 15) >> 2, tofs = 32 * ((lane >> 4) & 1) + 8 * (lane & 3);
    const unsigned kw_off = OFF_K + skey * KP + sch * 16, vw_off = OFF_V + skey * KP + sch * 16;
    const bf16* const sbase = P1 + (size_t)skey * PW + h * HDIM + sch * 8;
#define BLK_TOK(t) ((t) < n_loc ? (size_t)(b * SEQ + (R_lo + (t)) * 64) : (size_t)(TLAT + b * CTXL + ((t) - n_loc) * 64))
#define STAGE_LOAD(st) do { _Pragma("unroll") for (int s_ = 0; s_ < 2; ++s_) { const int t_ = 2 * (st) + s_; if (t_ < nb) { const bf16* src_ = sbase + BLK_TOK(t_) * PW; kreg[s_] = *(const v4u*)(src_ + AW); vreg[s_] = *(const v4u*)(src_ + 2 * AW); } } } while (0)
#define STAGE_WRITE(st, buf) do { _Pragma("unroll") for (int s_ = 0; s_ < 2; ++s_) { if (2 * (st) + s_ < nb) { *(LAS v4u*)(sm + kw_off + ((buf) * 2 + s_) * BLK_B) = kreg[s_]; *(LAS v4u*)(sm + vw_off + ((buf) * 2 + s_) * BLK_B) = vreg[s_]; } } } while (0)
#define VFRAG(dst, vb_, dh_, a_, s2_) do { const LAS unsigned char* vp_ = (vb_) + ((a_) + 16 * (s2_) + 4 * hi + tq) * KP + 64 * (dh_) + tofs; \
        const s16x4 lo_ = __builtin_bit_cast(s16x4, __builtin_amdgcn_ds_read_tr16_b64_v4i16((LAS s16x4*)vp_)), hi_ = __builtin_bit_cast(s16x4, __builtin_amdgcn_ds_read_tr16_b64_v4i16((LAS s16x4*)(vp_ + 8 * KP))); \
        dst = __builtin_shufflevector(lo_, hi_, 0, 1, 2, 3, 4, 5, 6, 7); } while (0)
#define PACK8(dst, x_, o_) do { v4u w_; w_.x = cvt_pk_bf16(x_[(o_) + 0], x_[(o_) + 1]); w_.y = cvt_pk_bf16(x_[(o_) + 2], x_[(o_) + 3]); w_.z = cvt_pk_bf16(x_[(o_) + 4], x_[(o_) + 5]); w_.w = cvt_pk_bf16(x_[(o_) + 6], x_[(o_) + 7]); dst = __builtin_bit_cast(bf16x8, w_); } while (0)
    v4u kreg[2], vreg[2];
    STAGE_LOAD(0); STAGE_WRITE(0, 0);
    __syncthreads();
    float m = -1e30f, lsum = 0.f; f32x16 o[2];
#pragma unroll
    for (int r = 0; r < 16; ++r) { o[0][r] = 0.f; o[1][r] = 0.f; }
    for (int st = 0; st < nsteps; ++st) {
        const int buf = st & 1;
        if (st + 1 < nsteps) STAGE_LOAD(st + 1);
#pragma unroll 1
        for (int s = 0; s < 2; ++s) {
            const int t = 2 * st + s; if (t >= nb) break;
            const LAS unsigned char* kb = sm + OFF_K + (buf * 2 + s) * BLK_B; const LAS unsigned char* vb = sm + OFF_V + (buf * 2 + s) * BLK_B;
            if (!CTXQ && t < n_loc) {
                const int keyrow = R_lo + t;
                if (keyrow < w_lo || keyrow >= w_hi) continue;
                f32x16 sp;
#pragma unroll
                for (int r = 0; r < 16; ++r) sp[r] = 0.f;
#pragma unroll
                for (int kk = 0; kk < 4; ++kk) { const bf16x8 a = *(const LAS bf16x8*)(kb + (a0 + l32) * KP + kk * 32 + hi * 16); sp = MFMA32(a, qr[kk], sp); }
                const LAS float* brow = (const LAS float*)(sm + OFF_BIAS) + ((keyrow - qrow + 7) * 31 + 15 + a0 + 4 * hi - qc);
                const int wofs = ((unsigned)(keyrow - my_rs) < 8u) ? (a0 + 4 * hi - cs) : 4096;
                float bv[16];
#pragma unroll
                for (int r = 0; r < 16; ++r) bv[r] = brow[(r & 3) + 8 * (r >> 2)];
                asm volatile("" : "+v"(bv[0]), "+v"(bv[1]), "+v"(bv[2]), "+v"(bv[3]), "+v"(bv[4]), "+v"(bv[5]), "+v"(bv[6]), "+v"(bv[7]), "+v"(bv[8]), "+v"(bv[9]), "+v"(bv[10]), "+v"(bv[11]), "+v"(bv[12]), "+v"(bv[13]), "+v"(bv[14]), "+v"(bv[15]));
#pragma unroll
                for (int r = 0; r < 16; ++r) { const bool inw = (unsigned)((r & 3) + 8 * (r >> 2) + wofs) < 16u; sp[r] = inw ? sp[r] + bv[r] : -3e38f; }
                float mx = sp[0];
#pragma unroll
                for (int r = 1; r < 16; ++r) mx = fmaxf(mx, sp[r]);
                mx = fmaxf(mx, __shfl_xor(mx, 32));
                const float mn = fmaxf(m, mx), alpha = __builtin_amdgcn_exp2f(m - mn); m = mn;
                float ps = 0.f;
#pragma unroll
                for (int r = 0; r < 16; ++r) { sp[r] = __builtin_amdgcn_exp2f(sp[r] - mn); ps += sp[r]; }
                lsum = lsum * alpha + ps;
#pragma unroll
                for (int r = 0; r < 16; ++r) { o[0][r] *= alpha; o[1][r] *= alpha; }
                bf16x8 pb[2]; PACK8(pb[0], sp, 0); PACK8(pb[1], sp, 8);
#pragma unroll
                for (int dh = 0; dh < 2; ++dh)
#pragma unroll
                    for (int s2 = 0; s2 < 2; ++s2) { bf16x8 a; VFRAG(a, vb, dh, a0, s2); o[dh] = MFMA32(a, pb[s2], o[dh]); }
            } else {
                f32x16 sp[2];
#pragma unroll
                for (int p = 0; p < 2; ++p) {
#pragma unroll
                    for (int r = 0; r < 16; ++r) sp[p][r] = 0.f;
#pragma unroll
                    for (int kk = 0; kk < 4; ++kk) { const bf16x8 a = *(const LAS bf16x8*)(kb + (32 * p + l32) * KP + kk * 32 + hi * 16); sp[p] = MFMA32(a, qr[kk], sp[p]); }
                }
                float mx = sp[0][0];
#pragma unroll
                for (int r = 1; r < 16; ++r) mx = fmaxf(mx, sp[0][r]);
#pragma unroll
                for (int r = 0; r < 16; ++r) mx = fmaxf(mx, sp[1][r]);
                mx = fmaxf(mx, __shfl_xor(mx, 32));
                const float mn = fmaxf(m, mx), alpha = __builtin_amdgcn_exp2f(m - mn); m = mn;
                float ps = 0.f;
#pragma unroll
                for (int p = 0; p < 2; ++p)
#pragma unroll
                    for (int r = 0; r < 16; ++r) { sp[p][r] = __builtin_amdgcn_exp2f(sp[p][r] - mn); ps += sp[p][r]; }
                lsum = lsum * alpha + ps;
#pragma unroll
                for (int r = 0; r < 16; ++r) { o[0][r] *= alpha; o[1][r] *= alpha; }
                bf16x8 pb[2][2]; PACK8(pb[0][0], sp[0], 0); PACK8(pb[0][1], sp[0], 8); PACK8(pb[1][0], sp[1], 0); PACK8(pb[1][1], sp[1], 8);
#pragma unroll
                for (int dh = 0; dh < 2; ++dh)
#pragma unroll
                    for (int p = 0; p < 2; ++p)
#pragma unroll
                        for (int s2 = 0; s2 < 2; ++s2) { bf16x8 a; VFRAG(a, vb, dh, 32 * p, s2); o[dh] = MFMA32(a, pb[p][s2], o[dh]); }
            }
        }
        if (st + 1 < nsteps) STAGE_WRITE(st + 1, buf ^ 1);
        __syncthreads();
    }
    const float ltot = lsum + __shfl_xor(lsum, 32), inv = 1.f / ltot;
    bf16* yrow = YA + qtok * AW + h * HDIM + 4 * hi;
#pragma unroll
    for (int dh = 0; dh < 2; ++dh)
#pragma unroll
        for (int g = 0; g < 4; ++g) { v2u w; w.x = cvt_pk_bf16(o[dh][4 * g] * inv, o[dh][4 * g + 1] * inv); w.y = cvt_pk_bf16(o[dh][4 * g + 2] * inv, o[dh][4 * g + 3] * inv);
            *(v2u*)(yrow + 32 * dh + 8 * g) = w; }
#undef BLK_TOK
#undef STAGE_LOAD
#undef STAGE_WRITE
#undef VFRAG
#undef PACK8
}
}

__device__ __forceinline__ void conv_phase(Frame& F, const bf16* P1, bf16* YC, const float* wconv  , int nrows) {
    const int gw = blockIdx.x * NWAVES + F.wave, NGW = F.G * NWAVES, ch0 = F.lane * 8;
    float w0[8], w1[8], w2[8];
#pragma unroll
    for (int i = 0; i < 8; ++i) { w0[i] = wconv[ch0 + i]; w1[i] = wconv[CW + ch0 + i]; w2[i] = wconv[2 * CW + ch0 + i]; }
    for (int ck = gw; ck < nrows / 8; ck += NGW) {
        const int t0 = ck * 8; const int seq = t0 < TLAT ? SEQ : CTXL;
        const bool has_prev = (t0 % seq) != 0, has_next = ((t0 + 8) % seq) != 0;
        v4u cgv[10], uv[10], bgv[8];
#pragma unroll
        for (int i = 0; i < 10; ++i) { const int row = t0 - 1 + i; const bool ok = (i > 0 || has_prev) && (i < 9 || has_next);
            if (ok) { cgv[i] = *(const v4u*)(P1 + (size_t)row * PW + 3 * AW + CW + ch0); uv[i] = *(const v4u*)(P1 + (size_t)row * PW + 3 * AW + 2 * CW + ch0); }
            else { cgv[i] = (v4u){0u, 0u, 0u, 0u}; uv[i] = (v4u){0u, 0u, 0u, 0u}; } }
#pragma unroll
        for (int i = 0; i < 8; ++i) bgv[i] = *(const v4u*)(P1 + (size_t)(t0 + i) * PW + 3 * AW + ch0);
        float zp[8], zc[8], zn[8];
#define MKZ(dst, a_, b_) do { dst[0] = bf_lo(a_.x) * bf_lo(b_.x); dst[1] = bf_hi(a_.x) * bf_hi(b_.x); dst[2] = bf_lo(a_.y) * bf_lo(b_.y); dst[3] = bf_hi(a_.y) * bf_hi(b_.y); \
        dst[4] = bf_lo(a_.z) * bf_lo(b_.z); dst[5] = bf_hi(a_.z) * bf_hi(b_.z); dst[6] = bf_lo(a_.w) * bf_lo(b_.w); dst[7] = bf_hi(a_.w) * bf_hi(b_.w); } while (0)
        MKZ(zp, cgv[0], uv[0]); MKZ(zc, cgv[1], uv[1]);
#pragma unroll
        for (int i8 = 0; i8 < 8; ++i8) {
            MKZ(zn, cgv[i8 + 2], uv[i8 + 2]);
            const v4u g_ = bgv[i8];
            const float bgf[8] = {bf_lo(g_.x), bf_hi(g_.x), bf_lo(g_.y), bf_hi(g_.y), bf_lo(g_.z), bf_hi(g_.z), bf_lo(g_.w), bf_hi(g_.w)};
            float y[8];
#pragma unroll
            for (int i = 0; i < 8; ++i) y[i] = bgf[i] * (w0[i] * zp[i] + w1[i] * zc[i] + w2[i] * zn[i]);
            v4u w; w.x = cvt_pk_bf16(y[0], y[1]); w.y = cvt_pk_bf16(y[2], y[3]); w.z = cvt_pk_bf16(y[4], y[5]); w.w = cvt_pk_bf16(y[6], y[7]);
            *(v4u*)(YC + (size_t)(t0 + i8) * CW + ch0) = w;
#pragma unroll
            for (int i = 0; i < 8; ++i) { zp[i] = zc[i]; zc[i] = zn[i]; }
        }
#undef MKZ
    }
}

__device__ __forceinline__ void router_phase(Frame& F, const float* gain, const float* modl, const float* w_router) {
    LAS float* wr = (LAS float*)(F.lds);
    LAS unsigned* lc = (LAS unsigned*)(F.lds + 32768);
    LAS unsigned* tk = (LAS unsigned*)(F.lds + 32768 + 64);
    for (int i = F.tid; i < 1024 * 8; i += NWAVES * 64) wr[i] = w_router[i];
    if (F.tid < 8) lc[F.tid] = 0u;
    __syncthreads();
    unsigned* R = (unsigned*)(F.ws + WS_ROUTE);
    RowVec g, sh, sc; row_load(g, gain, F.lane);
    int cur_b = -1;
    for (int base = blockIdx.x * 64; base < TLAT; base += F.G * 64) {
#pragma unroll 1
        for (int i = 0; i < 8; ++i) {
            const int ti = F.wave * 8 + i, row = base + ti, b = row / SEQ;
            if (b != cur_b) { row_load(sh, modl + (size_t)b * 6144 + 3 * D, F.lane); row_load(sc, modl + (size_t)b * 6144 + 4 * D, F.lane); cur_b = b; }
            RowVec x; row_load(x, (const float*)(F.ws + WS_X) + (size_t)row * D, F.lane);
            const float r = row_rms_scale(x);
            float lg[8];
#pragma unroll
            for (int e = 0; e < 8; ++e) lg[e] = 0.f;
#pragma unroll
            for (int j = 0; j < 4; ++j) { const f32x4 hv = x.v[j] * r * g.v[j] * (1.f + sc.v[j]) + sh.v[j]; x.v[j] = hv;
#pragma unroll
                for (int q = 0; q < 4; ++q) { const LAS f32x4* wq = (const LAS f32x4*)(wr + (256 * j + 4 * F.lane + q) * 8); const f32x4 wa = wq[0], wb = wq[1];
                    lg[0] += hv[q] * wa.x; lg[1] += hv[q] * wa.y; lg[2] += hv[q] * wa.z; lg[3] += hv[q] * wa.w; lg[4] += hv[q] * wb.x; lg[5] += hv[q] * wb.y; lg[6] += hv[q] * wb.z; lg[7] += hv[q] * wb.w; } }
            row_store_fp8(x, F.ws + WS_YE + (size_t)row * D, F.lane, S_H2);
#pragma unroll
            for (int e = 0; e < 8; ++e) lg[e] = wave_sum(lg[e]);
            int i1 = 0; float v1 = lg[0];
#pragma unroll
            for (int e = 1; e < 8; ++e) if (lg[e] > v1) { v1 = lg[e]; i1 = e; }
            int i2 = -1; float v2 = -3e38f;
#pragma unroll
            for (int e = 0; e < 8; ++e) if (e != i1 && lg[e] > v2) { v2 = lg[e]; i2 = e; }
            if (F.lane == 0) {
                const float e2 = __expf(v2 - v1), p1 = 1.f / (1.f + e2), p2 = e2 * p1;
                const unsigned lp1 = __hip_atomic_fetch_add(lc + i1, 1u, __ATOMIC_RELAXED, __HIP_MEMORY_SCOPE_WORKGROUP), lp2 = __hip_atomic_fetch_add(lc + i2, 1u, __ATOMIC_RELAXED, __HIP_MEMORY_SCOPE_WORKGROUP);
                tk[ti * 6 + 0] = (unsigned)i1; tk[ti * 6 + 1] = (unsigned)i2; tk[ti * 6 + 2] = lp1; tk[ti * 6 + 3] = lp2; tk[ti * 6 + 4] = __float_as_uint(p1); tk[ti * 6 + 5] = __float_as_uint(p2);
            }
        }
        __syncthreads();
        if (F.tid < 8) lc[8 + F.tid] = __hip_atomic_fetch_add(F.ctl + CW_FILL + 64 * F.tid, lc[F.tid], RLX_AGENT);
        __syncthreads();
        if (F.tid < 64) { const int row = base + F.tid; const unsigned e1 = tk[F.tid * 6], e2 = tk[F.tid * 6 + 1];
            R[row] = e1 | (e2 << 8); R[TLAT + row] = lc[8 + e1] + tk[F.tid * 6 + 2]; R[2 * TLAT + row] = lc[8 + e2] + tk[F.tid * 6 + 3]; R[3 * TLAT + row] = tk[F.tid * 6 + 4]; R[4 * TLAT + row] = tk[F.tid * 6 + 5]; }
        __syncthreads();
        if (F.tid < 8) lc[F.tid] = 0u;
        __syncthreads();
    }
}
__device__ __forceinline__ void moe_table(Frame& F, LAS int* tab) {
    if (F.tid == 0) { int acc = 0;
        for (int e = 0; e < 8; ++e) { tab[e] = acc; const unsigned c = __hip_atomic_load(F.ctl + CW_FILL + 64 * e, RLX_AGENT); acc += (int)((c + 255u) >> 8); }
        tab[8] = acc; }
    __syncthreads();
}
__device__ __forceinline__ void scatter_h2_phase(Frame& F, LAS int* tab) {
    const unsigned* R = (const unsigned*)(F.ws + WS_ROUTE);
    unsigned char* H2P = F.ws + WS_RA; const unsigned char* H2T = F.ws + WS_YE;
    const int gw = blockIdx.x * NWAVES + F.wave, NGW = F.G * NWAVES;
    for (int row0 = gw * 4; row0 < TLAT; row0 += NGW * 4) {
        v4u v[4]; size_t s1[4], s2[4];
#pragma unroll
        for (int i = 0; i < 4; ++i) { const int row = row0 + i; v[i] = *(const GAS v4u*)(H2T + (size_t)row * D + F.lane * 16);
            const unsigned ee = R[row]; const int e1 = ee & 255u, e2 = ee >> 8;
            s1[i] = (size_t)tab[e1] * 256 + R[TLAT + row]; s2[i] = (size_t)tab[e2] * 256 + R[2 * TLAT + row]; }
#pragma unroll
        for (int i = 0; i < 4; ++i) { *(GAS v4u*)(H2P + s1[i] * D + F.lane * 16) = v[i]; *(GAS v4u*)(H2P + s2[i] * D + F.lane * 16) = v[i]; }
    }
}
__device__ __forceinline__ void final_phase(Frame& F, const float* modl, const float* gfin, float* out, LAS int* tab) {
    const unsigned* R = (const unsigned*)(F.ws + WS_ROUTE);
    const bf16* YE = (const bf16*)(F.ws + WS_YE);
    const int gw = blockIdx.x * NWAVES + F.wave, NGW = F.G * NWAVES, per = (TLAT + NGW - 1) / NGW;
    RowVec g, g2; row_load(g, gfin, F.lane);
    int cur_b = -1;
    for (int i = 0; i < per; ++i) {
        const int row = gw * per + i; if (row >= TLAT) break;
        const int b = row / SEQ;
        if (b != cur_b) { row_load(g2, modl + (size_t)b * 6144 + 5 * D, F.lane); cur_b = b; }
        RowVec x; row_load(x, (const float*)(F.ws + WS_X) + (size_t)row * D, F.lane);
        const unsigned ee = R[row]; const int e1 = ee & 255u, e2 = ee >> 8;
        const size_t s1 = (size_t)tab[e1] * 256 + R[TLAT + row], s2 = (size_t)tab[e2] * 256 + R[2 * TLAT + row];
        const float p1 = __uint_as_float(R[3 * TLAT + row]), p2 = __uint_as_float(R[4 * TLAT + row]);
        const GAS v2u* y1 = (const GAS v2u*)(YE + s1 * D) + F.lane; const GAS v2u* y2 = (const GAS v2u*)(YE + s2 * D) + F.lane;
#pragma unroll
        for (int j = 0; j < 4; ++j) { const v2u a = y1[64 * j], c = y2[64 * j];
            f32x4 y; y.x = p1 * bf_lo(a.x) + p2 * bf_lo(c.x); y.y = p1 * bf_hi(a.x) + p2 * bf_hi(c.x); y.z = p1 * bf_lo(a.y) + p2 * bf_lo(c.y); y.w = p1 * bf_hi(a.y) + p2 * bf_hi(c.y);
            x.v[j] = x.v[j] + g2.v[j] * y; }
        const float r = row_rms_scale(x);
        GAS f32x4* o = (GAS f32x4*)(out + (size_t)row * D) + F.lane;
#pragma unroll
        for (int j = 0; j < 4; ++j) o[64 * j] = x.v[j] * r * g.v[j];
    }
}


#ifndef REPEAT_MASK
#define REPEAT_MASK 0u
#endif
#ifndef REPEAT_EXTRA
#define REPEAT_EXTRA 2
#endif
#ifndef PH_MASK
#define PH_MASK 0xFFFFFu
#endif
#define PH_ON(k) (((PH_MASK) >> (k)) & 1u)
#define IN(k) (lo <= (k) && (k) < hi)
#define BOTH(k) (IN(k) && IN((k) + 1))
#define GRID_BAR() do { if (N_LAUNCHES == 1) xcd_barrier(bar); } while (0)
template <int L>
__device__ __forceinline__ void mixer_layer(Frame& F, const XcdBarrier& bar, int lo, int hi) {
    constexpr int pb = 1 + 9 * L;
    constexpr int mrows = (L == 0) ? TALL : TLAT;
    if (PH_ON(pb) && IN(pb)) { modulate_phase(F, L == 0, F.in[6] + L * D, (const float*)(F.ws + WS_MOD) + (size_t)L * 9 * 6144, 0, D, (bf16*)(F.ws + WS_RA), TALL, F.ws + WS_H8, mrows); if (BOTH(pb)) GRID_BAR(); }
    if (PH_ON(pb + 1) && IN(pb + 1)) {
        const unsigned char* wm = F.ws + (L == 0 ? WS_WM0 : WS_WM1);
        constexpr int nwg1 = (L == 0) ? (TALL / 256) * 12 : 64 * 12 + 32;
        { pg8::Gemm g{(const bf16*)(F.ws + WS_RA), (const bf16*)(wm + WM_G1), TALL, 3072, 1024, (size_t)3072 * 128};
          pg8::EpiProj E{(bf16*)(F.ws + WS_RB), 0.125f * LOG2E};
          if (L == 0) { pg8::StaticOrder S; S.init(TALL, 3072, F.G, (int)blockIdx.x); pg8::gemm_phase<pg8::EpiProj, pg8::StaticOrder, PG8_ALIGN, PG8_SP2>(F.lds + RING_OFF, g, S, E); }
          else { pg8::ProjL1Order S; S.init(F.G, (int)blockIdx.x); pg8::gemm_phase<pg8::EpiProj, pg8::ProjL1Order, PG8_ALIGN, PG8_SP2>(F.lds + RING_OFF, g, S, E); } }
        { const int c2 = (int)((blockIdx.x + F.G - (unsigned)(nwg1 % F.G)) % F.G);
          pg8::Gemm g{(const bf16*)(F.ws + WS_H8), (const bf16*)(wm + WM_G8), mrows, 2048, 512, (size_t)2048 * 128};
          pg8::EpiGate E{(bf16*)(F.ws + WS_GT), F.in[14] + L * GW, 1.f / (S_H2 * S_W)};
          pg8::StaticOrder S; S.init(mrows, 2048, F.G, c2); pg8::gemm_phase<pg8::EpiGate, pg8::StaticOrder, PG8_ALIGN, PG8_SP2, true>(F.lds + RING_OFF, g, S, E);
          constexpr int nwg2 = (mrows / 256) * 8;
          const int r12 = nwg1 % F.G + nwg2 % F.G; const bool some = r12 < F.G;
          const bool part = !some || (int)blockIdx.x >= r12; const int p = some ? (int)blockIdx.x - r12 : (int)blockIdx.x, n_part = some ? F.G - r12 : F.G;
          if (L == 0) filler_part(F, part, p, n_part, DW_PB0, DW_PD0A); else filler_part(F, part, p, n_part, DW_PB1, DW_END); }
        if (BOTH(pb + 1)) GRID_BAR();
    }
    if (PH_ON(pb + 2) && IN(pb + 2)) {
        const bf16* P1 = (const bf16*)(F.ws + WS_RB); bf16* YA = (bf16*)(F.ws + WS_RA); bf16* YC = (bf16*)(F.ws + WS_RA + (size_t)TALL * AW * 2);
        const float* rpb = F.in[10] + (size_t)L * NHEAD * 465;
#ifndef ATT_REPS
#define ATT_REPS 1
#endif
#ifndef CONV_REPS
#define CONV_REPS 1
#endif
        for (int rep = 0; rep < ATT_REPS; ++rep) {
        for (int u = blockIdx.x; u < 512; u += F.G) { const int b = u >> 6, h = (u >> 3) & 7, r0 = (u & 7) * 4; att::attn_unit<false>(F.lds + RING_OFF, P1, YA, rpb + h * 465, b, h, r0); }
        if (L == 0) for (int v = (int)blockIdx.x - (F.G - 64); v >= 0 && v < 64; v += F.G) att::attn_unit<true>(F.lds + RING_OFF, P1, YA, rpb, v >> 3, v & 7, 0);
        }
        for (int rep = 0; rep < CONV_REPS; ++rep) conv_phase(F, P1, YC, F.in[9] + (size_t)L * 3 * CW, mrows);
        if (BOTH(pb + 2)) GRID_BAR();
    }
    if (PH_ON(pb + 3) && IN(pb + 3)) {
        const unsigned char* wm = F.ws + (L == 0 ? WS_WM0 : WS_WM1);
        bf16* MG = (bf16*)(F.ws + WS_RB); const bf16* GT = (const bf16*)(F.ws + WS_GT);
        pg8::StaticOrder S; S.init(mrows, 1024, F.G, (int)blockIdx.x);
        { pg8::Gemm g{(const bf16*)(F.ws + WS_RA), (const bf16*)(wm + WM_A), mrows, 1024, 512, (size_t)1024 * 128}; pg8::EpiMerge<false> E{MG, GT, 0};
          pg8::gemm_phase<pg8::EpiMerge<false>, pg8::StaticOrder, PG8_ALIGN, PG8_SP2>(F.lds + RING_OFF, g, S, E); if (L == 0) filler(F, TALL / 256 * 4, DW_PD0A, DW_PD0B); }
        { pg8::Gemm g{(const bf16*)(F.ws + WS_RA + (size_t)TALL * AW * 2), (const bf16*)(wm + WM_C), mrows, 1024, 512, (size_t)1024 * 128}; pg8::EpiMerge<true> E{MG, GT, 1024};
          pg8::gemm_phase<pg8::EpiMerge<true>, pg8::StaticOrder, PG8_ALIGN, PG8_SP2>(F.lds + RING_OFF, g, S, E); if (L == 0) filler(F, TALL / 256 * 4, DW_PD0B, DW_PE0); }
        if (BOTH(pb + 3)) GRID_BAR();
    }
    if (PH_ON(pb + 4) && IN(pb + 4)) {
        float* X = (float*)(F.ws + WS_X);
        pg8::StaticOrder S; S.init(mrows, 1024, F.G, (int)blockIdx.x);
        pg8::Gemm g{(const bf16*)(F.ws + WS_RB), (const bf16*)(F.ws + (L == 0 ? WS_WM0 : WS_WM1) + WM_O), mrows, 1024, 1024, (size_t)1024 * 128};
        pg8::EpiResid E{L == 0 ? F.in[0] : X, L == 0 ? F.in[2] : X + (size_t)TLAT * D, X, (const float*)(F.ws + WS_MOD) + (size_t)L * 9 * 6144 + 2 * D};
        pg8::gemm_phase<pg8::EpiResid, pg8::StaticOrder, PG8_ALIGN, PG8_SP2>(F.lds + RING_OFF, g, S, E);
        if (L == 0) filler(F, TALL / 256 * 4, DW_PE0, DW_PG0);
        if (BOTH(pb + 4)) GRID_BAR();
    }
}
struct Args { const float* in[24]; float* out; unsigned char* ws; int ph_lo, ph_hi; };
__global__ void __launch_bounds__(NWAVES * 64, 2) fwd(Args args) {
    extern __shared__ __attribute__((aligned(16))) unsigned char lds[];
    Frame F;
    F.lds = (LAS unsigned char*)lds;
    F.MISC = (volatile LAS unsigned*)(F.lds + MISC_OFF);
    F.tid = threadIdx.x; F.lane = F.tid & 63; F.wave = __builtin_amdgcn_readfirstlane(F.tid >> 6);
    F.G = gridDim.x; F.ws = args.ws; F.ctl = (unsigned*)(args.ws + WS_CTL); F.in = args.in;
    for (int u = F.tid; u < (LDS_BYTES - LDSCTL_OFF) / 4; u += NWAVES * 64) ((LAS unsigned*)(F.lds + LDSCTL_OFF))[u] = 0u;
    __syncthreads();
    XcdBarrier bar; bar.bar = F.ctl + CW_BAR; bar.x = 0; bar.st = nullptr;
    if (N_LAUNCHES == 1) bar = xcd_barrier_post(F.ctl + CW_BAR, F.MISC + 8);
    const int lo = args.ph_lo, hi = args.ph_hi;
    float* X = (float*)(F.ws + WS_X);
    const float* MOD = (const float*)(F.ws + WS_MOD);
    LAS int* tab = (LAS int*)(F.lds + LDSCTL_OFF + 64);

    if (PH_ON(0) && IN(0)) { p0_prologue(F); if (BOTH(0)) GRID_BAR(); }
    mixer_layer<0>(F, bar, lo, hi);
    if (PH_ON(6) || PH_ON(7) || PH_ON(8)) {
        const float* modl = MOD; bf16* H2 = (bf16*)(F.ws + WS_RA); bf16* HID = (bf16*)(F.ws + WS_RB);
        if (PH_ON(6) && IN(6)) { modulate_phase(F, false, F.in[7], modl, 3 * D, 4 * D, H2, TALL); if (BOTH(6)) GRID_BAR(); }
        if (PH_ON(7) && IN(7)) {
            pg8::StaticOrder S; S.init(TALL, 5632, F.G, (int)blockIdx.x);
            pg8::Gemm g{H2, (const bf16*)(F.ws + WS_WD + WD_GU), TALL, 5632, 1024, (size_t)5632 * 128}; pg8::EpiSwiGLU E{HID};
            pg8::gemm_phase<pg8::EpiSwiGLU, pg8::StaticOrder, PG8_ALIGN, PG8_SP2>(F.lds + RING_OFF, g, S, E);
            filler(F, TALL / 256 * 22, DW_PG0, DW_PH0);
            if (BOTH(7)) GRID_BAR();
        }
        if (PH_ON(8) && IN(8)) {
            pg8::StaticOrder S; S.init(TALL, 1024, F.G, (int)blockIdx.x);
            pg8::Gemm g{HID, (const bf16*)(F.ws + WS_WD + WD_DN), TALL, 1024, 2816, (size_t)1024 * 128};
            pg8::EpiResid E{X, X + (size_t)TLAT * D, X, modl + 5 * D};
            pg8::gemm_phase<pg8::EpiResid, pg8::StaticOrder, PG8_ALIGN, PG8_SP2>(F.lds + RING_OFF, g, S, E);
#ifndef EXP_PH0_IN_P0
            filler(F, TALL / 256 * 4, DW_PH0, DW_PB1);
#endif
            if (BOTH(8)) GRID_BAR();
        }
    }
    mixer_layer<1>(F, bar, lo, hi);
    {
        const float* modl = MOD + (size_t)9 * 6144;
        if (PH_ON(15) && IN(15)) { router_phase(F, F.in[7] + D, modl, F.in[19]); if (BOTH(15)) GRID_BAR(); }
        if (PH_ON(16) && IN(16)) { moe_table(F, tab); scatter_h2_phase(F, tab); if (BOTH(16)) GRID_BAR(); }
        if (PH_ON(17) && IN(17)) {
            moe_table(F, tab);
            pg8::MoEOrder S{tab, 22, F.G, (int)((blockIdx.x & 7) * (F.G >> 3) + (blockIdx.x >> 3))};
            pg8::Gemm g{(const bf16*)(F.ws + WS_RA), (const bf16*)(F.ws + WS_WE), SLOTS_MAX, 8 * 5632, 512, (size_t)NEXP * 5632 * 128}; pg8::EpiSwiGLU8 E{F.ws + WS_RB, 1.f / (S_H2 * S_W), S_HID};
            pg8::gemm_phase<pg8::EpiSwiGLU8, pg8::MoEOrder, PG8_ALIGN, PG8_SP2, true>(F.lds + RING_OFF, g, S, E);
            if (BOTH(17)) GRID_BAR();
        }
        if (PH_ON(18) && IN(18)) {
            moe_table(F, tab);
            pg8::MoEOrder S{tab, 4, F.G, (int)((blockIdx.x & 7) * (F.G >> 3) + (blockIdx.x >> 3))};
            pg8::Gemm g{(const bf16*)(F.ws + WS_RB), (const bf16*)(F.ws + WS_WED), SLOTS_MAX, 8 * 1024, 1408, (size_t)NEXP * 1024 * 128}; pg8::EpiYE E{(bf16*)(F.ws + WS_YE), 1.f / (S_HID * S_W)};
            pg8::gemm_phase<pg8::EpiYE, pg8::MoEOrder, PG8_ALIGN, PG8_SP2, true>(F.lds + RING_OFF, g, S, E);
            if (BOTH(18)) GRID_BAR();
        }
        if (PH_ON(19) && IN(19)) { moe_table(F, tab); final_phase(F, modl, F.in[23], args.out, tab); }
    }
#undef IN
#undef BOTH
#undef GRID_BAR
}

extern "C" void kernel_launch(void* const* d_in, const int* in_sizes, int n_in, void* d_out, int out_size, void* d_ws, size_t ws_size, hipStream_t stream) {
    static int grid = 0;
    if (grid == 0) {
        if (n_in != 24 || out_size != TLAT * D || ws_size < WS_END) { fprintf(stderr, "kernel_launch: unexpected shapes / workspace (%d inputs, out %d, ws %zu); nothing launched\n", n_in, out_size, ws_size); grid = -1; return; }
        int dev = 0, cus = 0, per_cu = 0;
        if (hipGetDevice(&dev) != hipSuccess || hipDeviceGetAttribute(&cus, hipDeviceAttributeMultiprocessorCount, dev) != hipSuccess) { grid = -1; return; }
        if (hipFuncSetAttribute((const void*)fwd, hipFuncAttributeMaxDynamicSharedMemorySize, LDS_BYTES) != hipSuccess) { fprintf(stderr, "kernel_launch: hipFuncSetAttribute failed\n"); grid = -1; return; }
        if (hipOccupancyMaxActiveBlocksPerMultiprocessor(&per_cu, (const void*)fwd, NWAVES * 64, LDS_BYTES) != hipSuccess || per_cu < 1) fprintf(stderr, "kernel_launch: occupancy query reports %d\n", per_cu);
        (void)hipGetLastError();
        grid = cus;
    }
    if (grid < 0) return;
    if (hipMemsetAsync((char*)d_ws + WS_CTL, 0, CTL_ZERO_BYTES, stream) != hipSuccess) return;
    Args a{};
    for (int i = 0; i < 24; ++i) a.in[i] = (const float*)d_in[i];
    a.out = (float*)d_out; a.ws = (unsigned char*)d_ws;
    if (N_LAUNCHES == 1) { a.ph_lo = 0; a.ph_hi = NPHASE + 1; hipLaunchKernelGGL(fwd, dim3(grid), dim3(NWAVES * 64), LDS_BYTES, stream, a); }
    else for (int p = 0; p <= NPHASE; ++p) { if (p == 9) continue; a.ph_lo = p; a.ph_hi = p + 1;
        const int reps = 1 + ((((unsigned)(REPEAT_MASK)) >> p) & 1u) * REPEAT_EXTRA;
        for (int r = 0; r < reps; ++r) hipLaunchKernelGGL(fwd, dim3(grid), dim3(NWAVES * 64), LDS_BYTES, stream, a); }
}
```

```cpp
#include <hip/hip_runtime.h>
#include <cstdio>
#include <cstdint>
#ifndef MK_N_LAUNCHES
#define MK_N_LAUNCHES 1
#endif
namespace pg8 {
#define PG8_LAS __attribute__((address_space(3)))
typedef unsigned short bf16_t;
typedef short bf16x8 __attribute__((ext_vector_type(8)));
typedef float f32x4 __attribute__((ext_vector_type(4)));
typedef unsigned u32x4 __attribute__((ext_vector_type(4)));
typedef int i32x4 __attribute__((ext_vector_type(4)));
typedef int i32x8 __attribute__((ext_vector_type(8)));
constexpr int BM = 256, BK = 64, HALF = 128, HTB = HALF * BK * 2  , STAGE_BYTES = 8 * HTB, NXCD = 8, WGM = 8;

__host__ __device__ __forceinline__ int lds_byte(int r, int c) { const int st = (r >> 4) * 2 + (c >> 5), rr = r & 15, cc = c & 31, ob = rr * 64 + cc * 2; return st * 1024 + (ob ^ (((ob >> 9) & 1) << 5)); }
__host__ __device__ __forceinline__ void stage_rc(int b, int& R, int& C) { const int st = b / 1024, sb = b % 1024, swz = sb ^ (((sb >> 9) & 1) << 5); R = (st >> 1) * 16 + swz / 64; C = (st & 1) * 32 + (swz % 64) / 2; }
__host__ __device__ __forceinline__ int perm32(int rho) { const int n = rho >> 4, i = rho & 15; return 8 * (i >> 2) + 4 * n + (i & 3); }

struct Unit { int pm, pn, pc; };
struct Gemm { const bf16_t* A; const bf16_t* Bt; int M, N, K; size_t kstepB; };

struct StaticOrder {
    int nM, nN, nwg, G, c;
    __host__ __device__ void init(int M, int N, int G_, int c_) { nM = M / BM; nN = N / BM; nwg = nM * nN; G = G_; c = c_; }
    __host__ __device__ bool next(int i, Unit& u) const {
        const long L = (long)i * G + c; if (L >= nwg) return false;
        int wgid = (int)L; { const int q = nwg / NXCD, r = nwg % NXCD, xcd = wgid % NXCD, off = wgid / NXCD; wgid = (xcd < r ? xcd * (q + 1) : r * (q + 1) + (xcd - r) * q) + off; }
        const int nig = WGM * nN, gid = wgid / nig, fm = gid * WGM, gsz = (nM - fm) < WGM ? (nM - fm) : WGM;
        u.pm = fm + ((wgid % nig) % gsz); u.pn = (wgid % nig) / gsz; u.pc = u.pn; return true;
    }
    __device__ __forceinline__ void a_ready(const Unit&) const {}
    __device__ __forceinline__ void done(const Unit&) const {}
};


typedef float f32x2_t __attribute__((ext_vector_type(2))); typedef __bf16 bf16x2_t __attribute__((ext_vector_type(2)));
__device__ __forceinline__ unsigned cvt_pk_bf16(float lo, float hi) { f32x2_t v = {lo, hi}; bf16x2_t b = __builtin_convertvector(v, bf16x2_t); return __builtin_bit_cast(unsigned, b); }
__device__ __forceinline__ float bf_lo(unsigned w) { return __builtin_bit_cast(float, w << 16); }
__device__ __forceinline__ float bf_hi(unsigned w) { return __builtin_bit_cast(float, w & 0xffff0000u); }
__device__ __forceinline__ float fast_sigmoid(float x) { return __builtin_amdgcn_rcpf(1.0f + __builtin_amdgcn_exp2f(-1.4426950408889634f * x)); }

struct EpiProj {
    static constexpr bool PERM = true, AFTER_DRAIN = false;
    bf16_t* P1; float qscale;
    __device__ __forceinline__ void operator()(const f32x4 (&acc)[2][2][4][2], const Unit& u, int wr, int wc, int fr, int fq) const {
        const int row0 = u.pm * BM + wr * 64 + fr, cin = wc * 32 + 8 * fq;
        const float sc = (u.pc < 2) ? qscale : 1.0f;
#pragma unroll
        for (int ai = 0; ai < 2; ++ai)
#pragma unroll
            for (int m = 0; m < 4; ++m) { bf16_t* rowp = P1 + (size_t)(row0 + ai * HALF + m * 16) * 3072 + u.pc * BM + cin;
#pragma unroll
                for (int bj = 0; bj < 2; ++bj) { const f32x4 v0 = acc[ai][bj][m][0] * sc, v1 = acc[ai][bj][m][1] * sc;
                    u32x4 w; w.x = cvt_pk_bf16(v0[0], v0[1]); w.y = cvt_pk_bf16(v0[2], v0[3]); w.z = cvt_pk_bf16(v1[0], v1[1]); w.w = cvt_pk_bf16(v1[2], v1[3]);
                    *(u32x4*)(rowp + bj * HALF) = w; } }
    }
};
struct EpiGate {
    static constexpr bool PERM = true, AFTER_DRAIN = false;
    bf16_t* GT; const float* bgate; float dsc;
    __device__ __forceinline__ void operator()(const f32x4 (&acc)[2][2][4][2], const Unit& u, int wr, int wc, int fr, int fq) const {
        const int row0 = u.pm * BM + wr * 64 + fr, gcol = u.pc * BM + wc * 32 + 8 * fq;
        f32x4 bv[2][2];
#pragma unroll
        for (int bj = 0; bj < 2; ++bj)
#pragma unroll
            for (int n = 0; n < 2; ++n) bv[bj][n] = *(const f32x4*)(bgate + gcol + bj * HALF + 4 * n);
#pragma unroll
        for (int ai = 0; ai < 2; ++ai)
#pragma unroll
            for (int m = 0; m < 4; ++m) { bf16_t* rowp = GT + (size_t)(row0 + ai * HALF + m * 16) * 2048 + gcol;
#pragma unroll
                for (int bj = 0; bj < 2; ++bj) { const f32x4 v0 = acc[ai][bj][m][0] * dsc + bv[bj][0], v1 = acc[ai][bj][m][1] * dsc + bv[bj][1];
                    u32x4 w; w.x = cvt_pk_bf16(fast_sigmoid(v0[0]), fast_sigmoid(v0[1])); w.y = cvt_pk_bf16(fast_sigmoid(v0[2]), fast_sigmoid(v0[3]));
                    w.z = cvt_pk_bf16(fast_sigmoid(v1[0]), fast_sigmoid(v1[1])); w.w = cvt_pk_bf16(fast_sigmoid(v1[2]), fast_sigmoid(v1[3]));
                    *(u32x4*)(rowp + bj * HALF) = w; } }
    }
};

template <bool SECOND> struct EpiMerge {
    static constexpr bool PERM = true, AFTER_DRAIN = false;
    bf16_t* MG; const bf16_t* GT; int gofs;
    __device__ __forceinline__ void operator()(const f32x4 (&acc)[2][2][4][2], const Unit& u, int wr, int wc, int fr, int fq) const {
        const int row0 = u.pm * BM + wr * 64 + fr, col0 = u.pc * BM + wc * 32 + 8 * fq;
#pragma unroll
        for (int ai = 0; ai < 2; ++ai)
#pragma unroll
            for (int m = 0; m < 4; ++m) { const size_t row = (size_t)(row0 + ai * HALF + m * 16);
#pragma unroll
                for (int bj = 0; bj < 2; ++bj) {
                    const u32x4 g = *(const u32x4*)(GT + row * 2048 + gofs + col0 + bj * HALF);
                    const f32x4 a0 = acc[ai][bj][m][0], a1 = acc[ai][bj][m][1];
                    float o[8] = {bf_lo(g.x) * a0[0], bf_hi(g.x) * a0[1], bf_lo(g.y) * a0[2], bf_hi(g.y) * a0[3], bf_lo(g.z) * a1[0], bf_hi(g.z) * a1[1], bf_lo(g.w) * a1[2], bf_hi(g.w) * a1[3]};
                    bf16_t* dst = MG + row * 1024 + col0 + bj * HALF;
                    if (SECOND) { const u32x4 p = *(const u32x4*)dst;
                        o[0] += bf_lo(p.x); o[1] += bf_hi(p.x); o[2] += bf_lo(p.y); o[3] += bf_hi(p.y); o[4] += bf_lo(p.z); o[5] += bf_hi(p.z); o[6] += bf_lo(p.w); o[7] += bf_hi(p.w); }
                    u32x4 w; w.x = cvt_pk_bf16(o[0], o[1]); w.y = cvt_pk_bf16(o[2], o[3]); w.z = cvt_pk_bf16(o[4], o[5]); w.w = cvt_pk_bf16(o[6], o[7]);
                    *(u32x4*)dst = w; } }
    }
};

struct EpiResid {
    static constexpr bool PERM = false, AFTER_DRAIN = false;
    const float* base_lat; const float* base_ctx; float* out; const float* mod;
    __device__ __forceinline__ void operator()(const f32x4 (&acc)[2][2][4][2], const Unit& u, int wr, int wc, int fr, int fq) const {
        const int col0 = u.pc * BM + wc * 32 + 4 * fq;
        const float* gv = mod + (size_t)(u.pm < 64 ? (u.pm >> 3) : 8) * 6144 + col0;
        const float* base = (u.pm < 64 ? base_lat + (size_t)u.pm * BM * 1024 : base_ctx + (size_t)(u.pm - 64) * BM * 1024) + col0;
        float* o = out + (size_t)u.pm * BM * 1024 + col0;
        f32x4 g4[2][2];
#pragma unroll
        for (int bj = 0; bj < 2; ++bj)
#pragma unroll
            for (int n = 0; n < 2; ++n) g4[bj][n] = *(const f32x4*)(gv + bj * HALF + n * 16);
#pragma unroll
        for (int ai = 0; ai < 2; ++ai)
#pragma unroll
            for (int m = 0; m < 4; ++m) { const size_t off = (size_t)(ai * HALF + wr * 64 + m * 16 + fr) * 1024;
#pragma unroll
                for (int bj = 0; bj < 2; ++bj)
#pragma unroll
                    for (int n = 0; n < 2; ++n) { const f32x4 bs = *(const f32x4*)(base + off + bj * HALF + n * 16);
                        *(f32x4*)(o + off + bj * HALF + n * 16) = bs + g4[bj][n] * acc[ai][bj][m][n]; }
                if (m & 1) asm volatile("" ::: "memory"); }
    }
};

struct EpiSwiGLU {
    static constexpr bool PERM = true, AFTER_DRAIN = false;
    bf16_t* HID;
    __device__ __forceinline__ void operator()(const f32x4 (&acc)[2][2][4][2], const Unit& u, int wr, int wc, int fr, int fq) const {
        const int row0 = u.pm * BM + wr * 64 + fr, col0 = u.pc * HALF + wc * 32 + 8 * fq;
#pragma unroll
        for (int ai = 0; ai < 2; ++ai)
#pragma unroll
            for (int m = 0; m < 4; ++m) { float o[8];
#pragma unroll
                for (int n = 0; n < 2; ++n)
#pragma unroll
                    for (int j = 0; j < 4; ++j) { const float gte = acc[ai][0][m][n][j], up = acc[ai][1][m][n][j]; o[4 * n + j] = gte * fast_sigmoid(gte) * up; }
                u32x4 w; w.x = cvt_pk_bf16(o[0], o[1]); w.y = cvt_pk_bf16(o[2], o[3]); w.z = cvt_pk_bf16(o[4], o[5]); w.w = cvt_pk_bf16(o[6], o[7]);
                *(u32x4*)(HID + (size_t)(row0 + ai * HALF + m * 16) * 2816 + col0) = w; }
    }
};

struct EpiYE {
    static constexpr bool PERM = true, AFTER_DRAIN = false;
    bf16_t* YE; float sc;
    __device__ __forceinline__ void operator()(const f32x4 (&acc)[2][2][4][2], const Unit& u, int wr, int wc, int fr, int fq) const {
        const int row0 = u.pm * BM + wr * 64 + fr, col0 = u.pc * BM + wc * 32 + 8 * fq;
#pragma unroll
        for (int ai = 0; ai < 2; ++ai)
#pragma unroll
            for (int m = 0; m < 4; ++m) { bf16_t* rowp = YE + (size_t)(row0 + ai * HALF + m * 16) * 1024 + col0;
#pragma unroll
                for (int bj = 0; bj < 2; ++bj) { const f32x4 v0 = acc[ai][bj][m][0] * sc, v1 = acc[ai][bj][m][1] * sc;
                    u32x4 w; w.x = cvt_pk_bf16(v0[0], v0[1]); w.y = cvt_pk_bf16(v0[2], v0[3]); w.z = cvt_pk_bf16(v1[0], v1[1]); w.w = cvt_pk_bf16(v1[2], v1[3]);
                    *(u32x4*)(rowp + bj * HALF) = w; } }
    }
};
__device__ __forceinline__ float sat448(float v) { return __builtin_fminf(__builtin_fmaxf(v, -448.0f), 448.0f); }
__device__ __forceinline__ unsigned cvt4_fp8(float a, float b, float c, float d) {
    int w = __builtin_amdgcn_cvt_pk_fp8_f32(sat448(a), sat448(b), 0, false); w = __builtin_amdgcn_cvt_pk_fp8_f32(sat448(c), sat448(d), w, true); return (unsigned)w; }
struct EpiSwiGLU8 {
    static constexpr bool PERM = true, AFTER_DRAIN = false;
    unsigned char* HID; float si, so;
    __device__ __forceinline__ void operator()(const f32x4 (&acc)[2][2][4][2], const Unit& u, int wr, int wc, int fr, int fq) const {
        const int row0 = u.pm * BM + wr * 64 + fr, col0 = u.pc * HALF + wc * 32 + 8 * fq;
#pragma unroll
        for (int ai = 0; ai < 2; ++ai)
#pragma unroll
            for (int m = 0; m < 4; ++m) { float o[8];
#pragma unroll
                for (int n = 0; n < 2; ++n)
#pragma unroll
                    for (int j = 0; j < 4; ++j) { const float gte = acc[ai][0][m][n][j] * si, up = acc[ai][1][m][n][j] * si; o[4 * n + j] = gte * fast_sigmoid(gte) * up * so; }
                typedef unsigned u32x2 __attribute__((ext_vector_type(2)));
                u32x2 w; w.x = cvt4_fp8(o[0], o[1], o[2], o[3]); w.y = cvt4_fp8(o[4], o[5], o[6], o[7]);
                *(u32x2*)(HID + (size_t)(row0 + ai * HALF + m * 16) * 2816 + col0) = w; }
    }
};

struct ProjL1Order {
    StaticOrder S0; int G, c;
    __host__ __device__ void init(int G_, int c_) { S0.init(16384, 3072, G_, c_); G = G_; c = c_; }
    __host__ __device__ bool next(int i, Unit& u) const {
        const long L = (long)i * G + c; if (L < S0.nwg) return S0.next(i, u);
        const int r = (int)(L - S0.nwg); if (r >= 32) return false;
        u.pm = 64 + (r & 7); u.pn = 2 + (r >> 3); u.pc = u.pn; return true;
    }
    __device__ __forceinline__ void a_ready(const Unit&) const {}
    __device__ __forceinline__ void done(const Unit&) const {}
};
struct MoEOrder {
    const PG8_LAS int* tab; int NT, G, c;
    __device__ __forceinline__ bool next(int i, Unit& u) const {
        const int L = i * G + c; if (L >= tab[8] * NT) return false;
        int e = 0;
#pragma unroll
        for (int k = 1; k < 8; ++k) e += (L >= tab[k] * NT) ? 1 : 0;
        const int t0 = tab[e], nte = tab[e + 1] - t0, loc = L - t0 * NT;
        const int ct = loc / nte, rt = loc - ct * nte;
        u.pm = t0 + rt; u.pn = e * NT + ct; u.pc = ct; return true;
    }
    __device__ __forceinline__ void a_ready(const Unit&) const {}
    __device__ __forceinline__ void done(const Unit&) const {}
};
template <class Epi, class Sched, bool ALIGN_EPI = false, bool SP2 = false, bool FP8 = false>
__device__ __forceinline__ void gemm_phase(PG8_LAS unsigned char* lds, const Gemm g, const Sched& S, const Epi& E) {
    const int tid = threadIdx.x, wid = __builtin_amdgcn_readfirstlane(tid >> 6), lane = tid & 63, wr = wid >> 2, wc = wid & 3, fr = lane & 15, fq = lane >> 4;
    const int K = g.K, nt = K / BK;
    unsigned voffA[2], voffB[2];
#pragma unroll
    for (int i = 0; i < 2; ++i) { int R, C; stage_rc(tid * 16 + i * 8192, R, C); const int Rb = Epi::PERM ? ((R & ~31) + perm32(R & 31)) : R;
        voffA[i] = (unsigned)(R * K + C) * 2u; voffB[i] = (unsigned)(Rb * BK + C) * 2u; }
    const size_t kstep = (size_t)(BK * 2);
    const size_t hstep = (size_t)HALF * K * 2;
    const size_t tstep = 2 * hstep;
    const size_t kstepB = g.kstepB, hstepB = (size_t)HALF * BK * 2, tstepB = 2 * hstepB;
    const unsigned ldsw = (unsigned)wid * 1024u;
    const int aoff = lds_byte(wr * 64 + fr, fq * 8), boff = lds_byte(wc * 32 + fr, fq * 8);
#define PG8_SA(b, h) (((b) * 2 + (h)) * HTB)
#define PG8_SB(b, h) ((4 + (b) * 2 + (h)) * HTB)
#define PG8_STAGE(bufoff, gbase, voff) do { _Pragma("unroll") for (int _i = 0; _i < 2; ++_i) \
        __builtin_amdgcn_global_load_lds((const unsigned*)((const char*)(gbase) + (voff)[_i]), (PG8_LAS unsigned*)(lds + (bufoff) + ldsw + _i * 8192), 16, 0, 0); } while (0)
#define PG8_LDA(dst, b, h) do { _Pragma("unroll") for (int m = 0; m < 4; ++m) { if constexpr (FP8) { const i32x4 lo_ = *(const PG8_LAS i32x4*)(lds + PG8_SA(b, h) + aoff + m * 2048), hi_ = *(const PG8_LAS i32x4*)(lds + PG8_SA(b, h) + aoff + m * 2048 + 1024); \
        dst##8[m] = __builtin_shufflevector(lo_, hi_, 0, 1, 2, 3, 4, 5, 6, 7); } else { _Pragma("unroll") for (int k = 0; k < 2; ++k) dst[m][k] = *(const PG8_LAS bf16x8*)(lds + PG8_SA(b, h) + aoff + m * 2048 + k * 1024); } } } while (0)
#define PG8_LDB(dst, b, h) do { _Pragma("unroll") for (int n = 0; n < 2; ++n) { if constexpr (FP8) { const i32x4 lo_ = *(const PG8_LAS i32x4*)(lds + PG8_SB(b, h) + boff + n * 2048), hi_ = *(const PG8_LAS i32x4*)(lds + PG8_SB(b, h) + boff + n * 2048 + 1024); \
        dst##8[n] = __builtin_shufflevector(lo_, hi_, 0, 1, 2, 3, 4, 5, 6, 7); } else { _Pragma("unroll") for (int k = 0; k < 2; ++k) dst[n][k] = *(const PG8_LAS bf16x8*)(lds + PG8_SB(b, h) + boff + n * 2048 + k * 1024); } } } while (0)
#define PG8_MMA(ai, bj, At, Bt) do { __builtin_amdgcn_s_setprio(1); _Pragma("unroll") for (int m = 0; m < 4; ++m) _Pragma("unroll") for (int n = 0; n < 2; ++n) { \
        if constexpr (FP8) {   \
            asm volatile("v_mfma_f32_16x16x128_f8f6f4 %0, %1, %2, %0" : "+v"(acc[ai][bj][m][n]) : "v"(Bt##8[n]), "v"(At##8[m]));   \
        } else { _Pragma("unroll") for (int k = 0; k < 2; ++k) acc[ai][bj][m][n] = __builtin_amdgcn_mfma_f32_16x16x32_bf16(Bt[n][k], At[m][k], acc[ai][bj][m][n], 0, 0, 0); } } \
        __builtin_amdgcn_s_setprio(0); } while (0)
#define PG8_WAIT_V(n) asm volatile("s_waitcnt vmcnt(" #n ")" ::: "memory")
#define PG8_WAIT_L(n) asm volatile("s_waitcnt lgkmcnt(" #n ")" ::: "memory")
#define PG8_BAR __builtin_amdgcn_s_barrier()
#define PG8_SCHED __builtin_amdgcn_sched_barrier(0)
    Unit cur, nxt; int ui = 0;
    if (!S.next(0, cur)) return;
    f32x4 acc[2][2][4][2];
#pragma unroll
    for (int a = 0; a < 2; ++a)
#pragma unroll
        for (int b = 0; b < 2; ++b)
#pragma unroll
            for (int m = 0; m < 4; ++m)
#pragma unroll
                for (int n = 0; n < 2; ++n) acc[a][b][m][n] = (f32x4){0.f, 0.f, 0.f, 0.f};
    bf16x8 At[4][2], B0[2][2], B1[2][2]; i32x8 At8[4], B08[2], B18[2];
    const char* cA = (const char*)g.A + (size_t)cur.pm * tstep; const char* cB = (const char*)g.Bt + (size_t)cur.pn * tstepB;
    S.a_ready(cur);
    if constexpr (SP2) {
        PG8_STAGE(PG8_SB(0, 0), cB, voffB); PG8_STAGE(PG8_SB(0, 1), cB + hstepB, voffB); PG8_STAGE(PG8_SA(0, 0), cA, voffA); PG8_STAGE(PG8_SA(0, 1), cA + hstep, voffA);
        if (wr == 1) PG8_BAR;
        PG8_WAIT_V(2); PG8_BAR;
        PG8_STAGE(PG8_SB(1, 0), cB + kstepB, voffB); PG8_STAGE(PG8_SA(1, 0), cA + kstep, voffA); PG8_STAGE(PG8_SB(1, 1), cB + hstepB + kstepB, voffB);
        PG8_WAIT_V(6); PG8_BAR;
    } else {
        PG8_STAGE(PG8_SB(0, 0), cB, voffB); PG8_STAGE(PG8_SA(0, 0), cA, voffA); PG8_STAGE(PG8_SB(0, 1), cB + hstepB, voffB); PG8_STAGE(PG8_SA(0, 1), cA + hstep, voffA);
        if (wr == 1) PG8_BAR;
        PG8_WAIT_V(4); PG8_BAR;
        PG8_STAGE(PG8_SB(1, 0), cB + kstepB, voffB); PG8_STAGE(PG8_SA(1, 0), cA + kstep, voffA); PG8_STAGE(PG8_SB(1, 1), cB + hstepB + kstepB, voffB);
        PG8_WAIT_V(6); PG8_BAR;
    }
    for (;;) {
        const bool has_next = S.next(ui + 1, nxt);
        const char* nA = has_next ? (const char*)g.A + (size_t)nxt.pm * tstep : cA; const char* nB = has_next ? (const char*)g.Bt + (size_t)nxt.pn * tstepB : cB;
        for (int t = 0; t < nt; t += 2) {
            const bool last = (t == nt - 2);
            const char* a1 = cA + (size_t)(t + 1) * kstep;
            const char* a2 = last ? nA : cA + (size_t)(t + 2) * kstep; const char* b2 = last ? nB : cB + (size_t)(t + 2) * kstepB;
            const char* a3 = a2 + kstep; const char* b3 = b2 + kstepB;
            if (last && has_next) S.a_ready(nxt);
            if constexpr (SP2) {
            PG8_LDB(B0, 0, 0); PG8_LDB(B1, 0, 1); PG8_SCHED; PG8_LDA(At, 0, 0); PG8_STAGE(PG8_SA(1, 1), a1 + hstep, voffA);
            PG8_WAIT_V(8); PG8_WAIT_L(0); PG8_BAR; PG8_MMA(0, 0, At, B0); PG8_MMA(0, 1, At, B1); PG8_BAR; PG8_SCHED;
            PG8_LDA(At, 0, 1); PG8_STAGE(PG8_SB(0, 0), b2, voffB); PG8_STAGE(PG8_SB(0, 1), b2 + hstepB, voffB); PG8_STAGE(PG8_SA(0, 0), a2, voffA);
            PG8_WAIT_V(8); PG8_WAIT_L(0); PG8_BAR; PG8_MMA(1, 0, At, B0); PG8_MMA(1, 1, At, B1); PG8_BAR; PG8_SCHED;
            PG8_LDB(B0, 1, 0); PG8_LDB(B1, 1, 1); PG8_SCHED; PG8_LDA(At, 1, 0); PG8_STAGE(PG8_SA(0, 1), a2 + hstep, voffA);
            PG8_WAIT_V(8); PG8_WAIT_L(0); PG8_BAR; PG8_MMA(0, 0, At, B0); PG8_MMA(0, 1, At, B1); PG8_BAR; PG8_SCHED;
            PG8_LDA(At, 1, 1); PG8_STAGE(PG8_SB(1, 0), b3, voffB); PG8_STAGE(PG8_SB(1, 1), b3 + hstepB, voffB); PG8_STAGE(PG8_SA(1, 0), a3, voffA);
            PG8_WAIT_V(8); PG8_WAIT_L(0); PG8_BAR; PG8_MMA(1, 0, At, B0); PG8_MMA(1, 1, At, B1); PG8_BAR; PG8_SCHED;
            } else {
            PG8_LDB(B0, 0, 0); PG8_SCHED; PG8_LDA(At, 0, 0); PG8_STAGE(PG8_SA(1, 1), a1 + hstep, voffA);
            PG8_WAIT_L(8); PG8_BAR; PG8_WAIT_L(0); PG8_MMA(0, 0, At, B0); PG8_BAR; PG8_SCHED;
            PG8_LDB(B1, 0, 1); PG8_STAGE(PG8_SB(0, 0), b2, voffB);
            PG8_BAR; PG8_WAIT_L(0); PG8_MMA(0, 1, At, B1); PG8_BAR;
            PG8_LDA(At, 0, 1); PG8_STAGE(PG8_SA(0, 0), a2, voffA);
            PG8_BAR; PG8_WAIT_L(0); PG8_MMA(1, 0, At, B0); PG8_BAR; PG8_SCHED;
            PG8_STAGE(PG8_SB(0, 1), b2 + hstepB, voffB);
            PG8_WAIT_V(6); PG8_BAR; PG8_MMA(1, 1, At, B1); PG8_BAR;
            PG8_LDB(B0, 1, 0); PG8_SCHED; PG8_LDA(At, 1, 0); PG8_STAGE(PG8_SA(0, 1), a2 + hstep, voffA);
            PG8_WAIT_L(8); PG8_BAR; PG8_WAIT_L(0); PG8_MMA(0, 0, At, B0); PG8_BAR; PG8_SCHED;
            PG8_LDB(B1, 1, 1); PG8_STAGE(PG8_SB(1, 0), b3, voffB);
            PG8_BAR; PG8_WAIT_L(0); PG8_MMA(0, 1, At, B1); PG8_BAR;
            PG8_LDA(At, 1, 1); PG8_STAGE(PG8_SA(1, 0), a3, voffA);
            PG8_BAR; PG8_WAIT_L(0); PG8_MMA(1, 0, At, B0); PG8_BAR; PG8_SCHED;
            PG8_STAGE(PG8_SB(1, 1), b3 + hstepB, voffB);
            PG8_WAIT_V(6); PG8_BAR; PG8_MMA(1, 1, At, B1); PG8_BAR;
            }
        }
        if constexpr (FP8) {
            asm volatile("s_nop 15\n\ts_nop 15\n\ts_nop 7" : "+v"(acc[0][0][0][0]), "+v"(acc[0][0][0][1]), "+v"(acc[0][0][1][0]), "+v"(acc[0][0][1][1]), "+v"(acc[0][0][2][0]), "+v"(acc[0][0][2][1]), "+v"(acc[0][0][3][0]), "+v"(acc[0][0][3][1]));
            asm volatile("" : "+v"(acc[0][1][0][0]), "+v"(acc[0][1][0][1]), "+v"(acc[0][1][1][0]), "+v"(acc[0][1][1][1]), "+v"(acc[0][1][2][0]), "+v"(acc[0][1][2][1]), "+v"(acc[0][1][3][0]), "+v"(acc[0][1][3][1]));
            asm volatile("" : "+v"(acc[1][0][0][0]), "+v"(acc[1][0][0][1]), "+v"(acc[1][0][1][0]), "+v"(acc[1][0][1][1]), "+v"(acc[1][0][2][0]), "+v"(acc[1][0][2][1]), "+v"(acc[1][0][3][0]), "+v"(acc[1][0][3][1]));
            asm volatile("" : "+v"(acc[1][1][0][0]), "+v"(acc[1][1][0][1]), "+v"(acc[1][1][1][0]), "+v"(acc[1][1][1][1]), "+v"(acc[1][1][2][0]), "+v"(acc[1][1][2][1]), "+v"(acc[1][1][3][0]), "+v"(acc[1][1][3][1]));
        }
        if constexpr (ALIGN_EPI) { if (wr == 0) PG8_BAR; }
        if constexpr (!Epi::AFTER_DRAIN) { E(acc, cur, wr, wc, fr, fq); S.done(cur); }
        if (!has_next) break;
#pragma unroll
        for (int a = 0; a < 2; ++a)
#pragma unroll
            for (int b = 0; b < 2; ++b)
#pragma unroll
                for (int m = 0; m < 4; ++m)
#pragma unroll
                    for (int n = 0; n < 2; ++n) acc[a][b][m][n] = (f32x4){0.f, 0.f, 0.f, 0.f};
        cur = nxt; cA = nA; cB = nB; ++ui;
        if constexpr (ALIGN_EPI) { if (wr == 1) PG8_BAR; }
    }
    PG8_WAIT_V(0);
    if constexpr (!ALIGN_EPI) { if (wr == 0) PG8_BAR; }
    PG8_BAR;
    if constexpr (Epi::AFTER_DRAIN) { E.fused(acc, cur, wr, wc, fr, fq, lds, wid, lane); S.done(cur); }
#undef PG8_SA
#undef PG8_SB
#undef PG8_STAGE
#undef PG8_LDA
#undef PG8_LDB
#undef PG8_MMA
#undef PG8_WAIT_V
#undef PG8_WAIT_L
#undef PG8_BAR
#undef PG8_SCHED
}
}

#ifndef PG8_SP2
#define PG8_SP2 true
#endif
#ifndef PG8_ALIGN
#define PG8_ALIGN true
#endif

constexpr int NWAVES = 8;
constexpr int D = 1024, NB = 8, SEQ = 2048, CTXL = 256;
constexpr int TLAT = NB * SEQ, TCTX = NB * CTXL, TALL = TLAT + TCTX;
constexpr int NHEAD = 8, HDIM = 64, AW = 512, CW = 512, PW = 3072, GW = 2048, FF = 2816, NEXP = 8;
constexpr int SLOTS_MAX = 2 * TLAT + NEXP * 256;
constexpr float EPS = 1e-6f, LOG2E = 1.4426950408889634f;
constexpr int NPHASE = 19;
constexpr int N_LAUNCHES = MK_N_LAUNCHES;
static_assert(N_LAUNCHES == 1 || N_LAUNCHES == NPHASE, "MK_N_LAUNCHES is 1 or 19");

constexpr size_t MiB = 1u << 20;
constexpr size_t WS_CTL = 0, CTL_ZERO_BYTES = 1 * MiB;
constexpr size_t WS_MOD = 1 * MiB;
constexpr size_t WS_ROUTE = 2 * MiB;
constexpr size_t WS_X = 4 * MiB;
constexpr size_t WS_RA = 76 * MiB;
constexpr size_t WS_RB = 112 * MiB;
constexpr size_t WS_GT = WS_RB + 108 * MiB;
constexpr size_t WS_YE = WS_RB + 94 * MiB;
constexpr size_t WS_WM0 = 300 * MiB, WS_WM1 = 314 * MiB;
constexpr size_t WS_WD = 328 * MiB;
constexpr size_t WS_WE = 345 * MiB;
constexpr size_t WS_WED = WS_WE + 44 * MiB;
constexpr size_t WS_H8 = 412 * MiB;
constexpr size_t WS_END = 430 * MiB;
constexpr float S_H2 = 16.f, S_W = 256.f, S_HID = 8.f;
#ifndef PB1_FP8
#define PB1_FP8 0
#endif
constexpr size_t WM_G1 = 0, WM_G8 = 6 * MiB, WM_A = 10 * MiB, WM_C = 11 * MiB, WM_O = 12 * MiB;
constexpr size_t WD_GU = 0, WD_DN = 11 * MiB;
constexpr int CW_BAR = 4096;
constexpr int CW_FILL = 16384;

constexpr int RING_OFF = 0, RING_BYTES = 131072;
constexpr int LDSCTL_OFF = RING_BYTES, MISC_OFF = LDSCTL_OFF + 320;
constexpr int LDS_BYTES = 147456;

#define GAS __attribute__((address_space(1)))
#define LAS __attribute__((address_space(3)))
typedef unsigned short bf16;
typedef unsigned v4u __attribute__((ext_vector_type(4)));
typedef unsigned v2u __attribute__((ext_vector_type(2)));
typedef float f32x4 __attribute__((ext_vector_type(4)));
typedef float f32x16 __attribute__((ext_vector_type(16)));
typedef short bf16x8 __attribute__((ext_vector_type(8)));
typedef short s16x4 __attribute__((ext_vector_type(4)));
typedef GAS unsigned gu32;
#define RLX_AGENT __ATOMIC_RELAXED, __HIP_MEMORY_SCOPE_AGENT
#define LDS_WAIT() asm volatile("s_waitcnt lgkmcnt(0)" ::: "memory")
using pg8::cvt_pk_bf16; using pg8::bf_lo; using pg8::bf_hi;

#define XB_TMO      128
#define XB_XCNT(j)  (256  + 64 * (j))
#define XB_XSUB(j)  (1280 + 64 * (j))
#define XB_XGEN(j)  (2304 + 64 * (j))
#define XB_TOP      3328
#define XB_TOPGEN   3392
#define XCD_BAR_WORDS 3456
#define XB_SPIN_CAP (1u << 18)

__device__ __forceinline__ unsigned xb_ld(unsigned* p)              { return __hip_atomic_load(p, __ATOMIC_RELAXED, __HIP_MEMORY_SCOPE_AGENT); }
__device__ __forceinline__ unsigned xb_add(unsigned* p, unsigned v) { return __hip_atomic_fetch_add(p, v, __ATOMIC_RELAXED, __HIP_MEMORY_SCOPE_AGENT); }
__device__ __forceinline__ unsigned xb_xcc_id() { return (unsigned)__builtin_amdgcn_s_getreg((3 << 11) | 20) & 0xFu; }
#define XB_SPIN(cond, bar) do { unsigned _sp = 0; while (cond) { __builtin_amdgcn_s_sleep(1); \
    if ((++_sp & 255u) == 0u) { if (xb_ld(&(bar)[XB_TMO])) break; if (_sp > XB_SPIN_CAP) { atomicAdd(&(bar)[XB_TMO], 1u); break; } } } } while (0)

struct XcdBarrier {
    unsigned* bar; unsigned x;
    volatile LAS unsigned* st;
};

__device__ __forceinline__ XcdBarrier xcd_barrier_post(unsigned* bar, volatile LAS unsigned* st) {
    XcdBarrier b; b.bar = bar; b.x = xb_xcc_id(); b.st = st;
    if (threadIdx.x == 0) (void)xb_add(&bar[XB_XCNT(b.x)], 1u);
    return b;
}
__device__ __forceinline__ void xcd_barrier_complete(unsigned* bar, unsigned x, unsigned& nloc, unsigned& nx) {
    const unsigned G = gridDim.x * gridDim.y * gridDim.z;
    unsigned sum, cnt, mine, sp = 0u;
    for (;;) {
        sum = 0u; cnt = 0u; mine = 0u;
#pragma unroll
        for (unsigned j = 0; j < 16; ++j) { const unsigned c = xb_ld(&bar[XB_XCNT(j)]); sum += c; cnt += (c > 0u) ? 1u : 0u; mine = (j == x) ? c : mine; }
        if (sum == G) break;
        __builtin_amdgcn_s_sleep(1);
        if ((++sp & 255u) == 0u) { if (xb_ld(&bar[XB_TMO])) break; if (sp > XB_SPIN_CAP) { atomicAdd(&bar[XB_TMO], 1u); break; } }
    }
    nloc = mine > 0u ? mine : 1u; nx = cnt > 0u ? cnt : 1u;
}

__device__ __forceinline__ void xcd_barrier(const XcdBarrier& b) {
    asm volatile("s_waitcnt vmcnt(0)" ::: "memory");
    __syncthreads();
    if (threadIdx.x == 0) {
        unsigned* bar = b.bar;
        __builtin_amdgcn_s_waitcnt(0);
        unsigned nloc = b.st[0], nx = b.st[1];
        if (nloc == 0u) { xcd_barrier_complete(bar, b.x, nloc, nx); b.st[0] = nloc; b.st[1] = nx; }
        const unsigned old = xb_add(&bar[XB_XSUB(b.x)], 1u);
        const unsigned gen = old / nloc;
        if (old + 1u == (gen + 1u) * nloc) {
            __builtin_amdgcn_fence(__ATOMIC_RELEASE, "agent");
            asm volatile("s_waitcnt vmcnt(0)" ::: "memory");
            const unsigned og = xb_add(&bar[XB_TOP], 1u);
            const unsigned tg = og / nx;
            if (og + 1u == (tg + 1u) * nx) xb_add(&bar[XB_TOPGEN], 1u);
            else XB_SPIN(xb_ld(&bar[XB_TOPGEN]) == tg, bar);
            __builtin_amdgcn_fence(__ATOMIC_ACQUIRE, "agent");
            xb_add(&bar[XB_XGEN(b.x)], 1u);
            asm volatile("s_waitcnt vmcnt(0)" ::: "memory");
        } else {
            XB_SPIN(xb_ld(&bar[XB_XGEN(b.x)]) == gen, bar);
            __builtin_amdgcn_fence(__ATOMIC_ACQUIRE, "agent");
            asm volatile("s_waitcnt vmcnt(0)" ::: "memory");
        }
    }
    __syncthreads();
}


struct Frame {
    LAS unsigned char* lds;
    volatile LAS unsigned* MISC;
    unsigned* ctl;
    unsigned char* ws;
    int tid, lane, wave, G;
    const float* const* in;
};

__device__ __forceinline__ float wave_sum(float v) {
#pragma unroll
    for (int o = 1; o < 64; o <<= 1) v += __shfl_xor(v, o);
    return v;
}
__device__ __forceinline__ float silu_f(float v) { return v / (1.f + __expf(-v)); }

#ifndef CONV_NT
#define CONV_NT 1
#endif
#if CONV_NT
#define CONV_LOAD(p) __builtin_nontemporal_load(p)
#else
#define CONV_LOAD(p) (*(p))
#endif
template <bool FP8>
__device__ __forceinline__ void convert_item(const float* W, int K, int N, unsigned char* WT, int rows_total, int row_off, int mode, float scale, LAS unsigned char* scr, int item, int lane) {
    constexpr int KT = FP8 ? 128 : 64;
    const int nblk = N / 64, kt = item / nblk, nb = item - kt * nblk, n0 = 64 * nb;
    const int drow0 = row_off + (mode == 0 ? n0 : ((n0 >> 7) << 8) + (n0 & 127) + (mode == 2 ? 128 : 0));
    const GAS float* src = (const GAS float*)(W + (size_t)(kt * KT) * N + n0) + lane;
    float v[KT];
#pragma unroll
    for (int i = 0; i < KT; ++i) v[i] = CONV_LOAD(src + (size_t)i * N);
    LAS v4u* wrow = (LAS v4u*)(scr + lane * 144);
#pragma unroll
    for (int q = 0; q < 8; ++q) { v4u o;
#pragma unroll
        for (int w = 0; w < 4; ++w) {
            if (FP8) o[w] = pg8::cvt4_fp8(v[16 * q + 4 * w] * scale, v[16 * q + 4 * w + 1] * scale, v[16 * q + 4 * w + 2] * scale, v[16 * q + 4 * w + 3] * scale);
            else o[w] = cvt_pk_bf16(v[(8 * q + 2 * w) % KT], v[(8 * q + 2 * w + 1) % KT]); }
        wrow[q] = o; }
    asm volatile("s_waitcnt lgkmcnt(0)" ::: "memory");
    GAS v4u* dst = (GAS v4u*)(WT + (size_t)kt * rows_total * 128 + (size_t)drow0 * 128) + lane;
    const LAS unsigned char* rrow = scr + (lane >> 3) * 144 + (lane & 7) * 16;
#pragma unroll
    for (int i = 0; i < 8; ++i) dst[64 * i] = *(const LAS v4u*)(rrow + i * 8 * 144);
    asm volatile("s_waitcnt lgkmcnt(0)" ::: "memory");
}

constexpr int I_IN = (1024 / 64) * (3072 / 64), I_GT = (1024 / 128) * (2048 / 64), I_AO = (512 / 64) * (1024 / 64), I_O = (1024 / 64) * (1024 / 64);
constexpr int I_MIX = I_IN + I_GT + 2 * I_AO + I_O;
constexpr int I_FG = (1024 / 64) * (2816 / 64), I_FD = (2816 / 64) * (1024 / 64), I_E = 2 * I_FG + I_FD;
constexpr int I_XG = (1024 / 128) * (2816 / 64), I_XD = (2816 / 128) * (1024 / 64), I_X = 2 * I_XG + I_XD;
constexpr int NDEF = I_E + I_MIX + NEXP * I_X;
__device__ __forceinline__ void mixer_item(Frame& F, int l, int r, LAS unsigned char* scr) {
    unsigned char* wm = F.ws + (l == 0 ? WS_WM0 : WS_WM1);
    if (r < I_IN) { convert_item<false>(F.in[8] + (size_t)l * 1024 * 3072, 1024, 3072, wm + WM_G1, 3072, 0, 0, 1.f, scr, r, F.lane); return; } r -= I_IN;
    if (r < I_GT) { convert_item<true>(F.in[13] + (size_t)l * 1024 * 2048, 1024, 2048, wm + WM_G8, 2048, 0, 0, S_W, scr, r, F.lane); return; } r -= I_GT;
    if (r < I_AO) { convert_item<false>(F.in[11] + (size_t)l * 512 * 1024, 512, 1024, wm + WM_A, 1024, 0, 0, 1.f, scr, r, F.lane); return; } r -= I_AO;
    if (r < I_AO) { convert_item<false>(F.in[12] + (size_t)l * 512 * 1024, 512, 1024, wm + WM_C, 1024, 0, 0, 1.f, scr, r, F.lane); return; } r -= I_AO;
    convert_item<false>(F.in[15] + (size_t)l * 1024 * 1024, 1024, 1024, wm + WM_O, 1024, 0, 0, 1.f, scr, r, F.lane);
}
__device__ __forceinline__ void deferred_item(Frame& F, int r, LAS unsigned char* scr) {
    if (r < I_E) {
        if (r < I_FG) { convert_item<false>(F.in[16], 1024, 2816, F.ws + WS_WD + WD_GU, 5632, 0, 1, 1.f, scr, r, F.lane); return; } r -= I_FG;
        if (r < I_FG) { convert_item<false>(F.in[17], 1024, 2816, F.ws + WS_WD + WD_GU, 5632, 0, 2, 1.f, scr, r, F.lane); return; } r -= I_FG;
        convert_item<false>(F.in[18], 2816, 1024, F.ws + WS_WD + WD_DN, 1024, 0, 0, 1.f, scr, r, F.lane); return;
    }
    r -= I_E;
    if (r < I_MIX) { mixer_item(F, 1, r, scr); return; }
    r -= I_MIX;
    const int e = r / I_X; r -= e * I_X;
    if (r < I_XG) { convert_item<true>(F.in[20] + (size_t)e * 1024 * 2816, 1024, 2816, F.ws + WS_WE, NEXP * 5632, e * 5632, 1, S_W, scr, r, F.lane); return; } r -= I_XG;
    if (r < I_XG) { convert_item<true>(F.in[21] + (size_t)e * 1024 * 2816, 1024, 2816, F.ws + WS_WE, NEXP * 5632, e * 5632, 2, S_W, scr, r, F.lane); return; } r -= I_XG;
    convert_item<true>(F.in[22] + (size_t)e * 2816 * 1024, 2816, 1024, F.ws + WS_WED, NEXP * 1024, e * 1024, 0, S_W, scr, r, F.lane);
}
__device__ __forceinline__ void filler(Frame& F, int nwg, int lo, int hi) {
    const int rem = nwg % F.G, c = (int)blockIdx.x;
    if (c < rem) return;
    LAS unsigned char* scr = F.lds + RING_OFF + F.wave * 9216;
    for (int it = lo + (c - rem) * NWAVES + F.wave; it < hi; it += (F.G - rem) * NWAVES) deferred_item(F, it, scr);
    __syncthreads();
}
__device__ __forceinline__ void filler_part(Frame& F, bool part, int p, int n_part, int lo, int hi) {
    if (!part) return;
    LAS unsigned char* scr = F.lds + RING_OFF + F.wave * 9216;
    for (int it = lo + p * NWAVES + F.wave; it < hi; it += n_part * NWAVES) deferred_item(F, it, scr);
    __syncthreads();
}
constexpr int DW_P0 = 0, DW_PB0 = 1400, DW_PD0A = 2600, DW_PD0B = 3796, DW_PE0 = 4596, DW_PG0 = 5996, DW_PH0 = 7296, DW_PB1 = 10696, DW_END = NDEF;
static_assert(DW_PG0 >= I_E && DW_PB1 >= I_E + I_MIX && DW_PB1 < NDEF, "deferred windows: dense FFN weights before PG0, layer-1 mixer weights before PB1");

__device__ __forceinline__ void p0_prologue(Frame& F) {
    const float* c = F.in[1]; const float* cctx = F.in[3]; const float* w_ada = F.in[4]; const float* b_ada = F.in[5];
    float* MOD = (float*)(F.ws + WS_MOD);
    LAS float* sl = (LAS float*)(F.lds);
    LAS float* red = (LAS float*)(F.lds + 9 * 1024 * 4);
    bool have_sl = false;
    for (int it = blockIdx.x; it < 2 * 128; it += F.G) {
        if (!have_sl) { for (int i = F.tid; i < 9 * 1024; i += NWAVES * 64) { const int j = i >> 10, k = i & 1023; sl[i] = silu_f(j < 8 ? c[j * 1024 + k] : cctx[k]); } have_sl = true; }
        __syncthreads();
        const int l = it >> 7, col0 = (it & 127) * 48, cl_ = F.lane < 48 ? F.lane : 47;
        const float* wp = w_ada + (size_t)l * 1024 * 6144 + (size_t)(F.wave * 128) * 6144 + col0 + cl_;
        float a[9];
#pragma unroll
        for (int j = 0; j < 9; ++j) a[j] = 0.f;
#pragma unroll 1
        for (int k0 = 0; k0 < 128; k0 += 32) { float wv[32];
#pragma unroll
            for (int k = 0; k < 32; ++k) wv[k] = wp[(size_t)(k0 + k) * 6144];
#pragma unroll
            for (int k = 0; k < 32; ++k)
#pragma unroll
                for (int j = 0; j < 9; ++j) a[j] += sl[j * 1024 + F.wave * 128 + k0 + k] * wv[k]; }
#pragma unroll
        for (int j = 0; j < 9; ++j) red[(F.wave * 9 + j) * 64 + F.lane] = a[j];
        __syncthreads();
        for (int i = F.tid; i < 9 * 64; i += NWAVES * 64) { const int j = i >> 6, cl = i & 63; if (cl < 48) { float s = 0.f;
#pragma unroll
            for (int w = 0; w < 8; ++w) s += red[(w * 9 + j) * 64 + cl];
            MOD[(size_t)(l * 9 + j) * 6144 + col0 + cl] = s + b_ada[l * 6144 + col0 + cl]; } }
    }
    const int gw = blockIdx.x * NWAVES + F.wave, NGW = F.G * NWAVES;
    __syncthreads();
    LAS unsigned char* scr = F.lds + RING_OFF + F.wave * 9216;
    for (int it = gw; it < I_MIX + DW_PB0; it += NGW) { if (it < I_MIX) mixer_item(F, 0, it, scr); else deferred_item(F, it - I_MIX, scr); }
#ifdef EXP_PH0_IN_P0
    for (int it = DW_PH0 + gw; it < DW_PB1; it += NGW) deferred_item(F, it, scr);
#endif
}

struct RowVec { f32x4 v[4]; };
__device__ __forceinline__ void row_load(RowVec& r, const float* p, int lane) {
    const GAS f32x4* q = (const GAS f32x4*)p + lane;
#pragma unroll
    for (int j = 0; j < 4; ++j) r.v[j] = q[64 * j];
}
__device__ __forceinline__ float row_rms_scale(const RowVec& x) {
    float s = 0.f;
#pragma unroll
    for (int j = 0; j < 4; ++j) s += (x.v[j].x * x.v[j].x + x.v[j].y * x.v[j].y) + (x.v[j].z * x.v[j].z + x.v[j].w * x.v[j].w);
    return rsqrtf(wave_sum(s) * (1.f / D) + EPS);
}
__device__ __forceinline__ void row_store_bf16(const RowVec& r, bf16* p, int lane) {
    GAS v2u* o = (GAS v2u*)p + lane;
#pragma unroll
    for (int j = 0; j < 4; ++j) { v2u w; w.x = cvt_pk_bf16(r.v[j].x, r.v[j].y); w.y = cvt_pk_bf16(r.v[j].z, r.v[j].w); o[64 * j] = w; }
}
__device__ __forceinline__ void row_store_fp8(const RowVec& r, unsigned char* p, int lane, float scale) {
    GAS unsigned* o = (GAS unsigned*)p + lane;
#pragma unroll
    for (int j = 0; j < 4; ++j) o[64 * j] = pg8::cvt4_fp8(r.v[j].x * scale, r.v[j].y * scale, r.v[j].z * scale, r.v[j].w * scale);
}
__device__ __forceinline__ const float* xrow_ptr(Frame& F, bool from_input, int row) {
    if (from_input) return row < TLAT ? F.in[0] + (size_t)row * D : F.in[2] + (size_t)(row - TLAT) * D;
    return (const float*)(F.ws + WS_X) + (size_t)row * D;
}
template <bool FP8OUT = false>
__device__ __forceinline__ void modulate_phase(Frame& F, bool from_input, const float* gain, const float* modl  , int sh_off, int sc_off, bf16* H, int nrows, unsigned char* H8 = nullptr, int nrows8 = 0) {
    const int gw = blockIdx.x * NWAVES + F.wave, NGW = F.G * NWAVES;
    const int per = (nrows + NGW - 1) / NGW;
    RowVec g, sh, sc; row_load(g, gain, F.lane);
    int cur_b = -1;
    for (int i = 0; i < per; ++i) {
        const int row = gw * per + i; if (row >= nrows) break;
        const int b = row < TLAT ? row / SEQ : 8;
        if (b != cur_b) { row_load(sh, modl + (size_t)b * 6144 + sh_off, F.lane); row_load(sc, modl + (size_t)b * 6144 + sc_off, F.lane); cur_b = b; }
        RowVec x; row_load(x, xrow_ptr(F, from_input, row), F.lane);
        const float r = row_rms_scale(x);
#pragma unroll
        for (int j = 0; j < 4; ++j) x.v[j] = x.v[j] * r * g.v[j] * (1.f + sc.v[j]) + sh.v[j];
        if (FP8OUT) row_store_fp8(x, (unsigned char*)H + (size_t)row * D, F.lane, S_H2); else row_store_bf16(x, H + (size_t)row * D, F.lane);
        if (H8 && row < nrows8) row_store_fp8(x, H8 + (size_t)row * D, F.lane, S_H2);
    }
}

namespace att {
constexpr int KP = 144;
constexpr int BLK_B = 64 * KP;
constexpr int OFF_K = 0, OFF_V = 4 * BLK_B, OFF_BIAS = 8 * BLK_B, ATT_LDS = OFF_BIAS + 2048;
__device__ __forceinline__ int pos32(int k) { const int s = k >> 4, k16 = k & 15; return 16 * s + 8 * ((k16 >> 2) & 1) + (((k16 >> 3) << 2) | (k16 & 3)); }
__device__ __forceinline__ int clampi(int v, int lo, int hi) { return v < lo ? lo : (v > hi ? hi : v); }
#define MFMA32(a, b, c) __builtin_amdgcn_mfma_f32_32x32x16_bf16((a), (b), (c), 0, 0, 0)

template <bool CTXQ>
__device__ __forceinline__ void attn_unit(LAS unsigned char* sm, const bf16* __restrict__ P1, bf16* __restrict__ YA, const float* __restrict__ rpb_lh, int b, int h, int r0) {
    const int tid = threadIdx.x, lane = tid & 63, l32 = lane & 31, hi = lane >> 5; const int wid = __builtin_amdgcn_readfirstlane(tid >> 6);
    const int R_lo = CTXQ ? 0 : clampi(r0 - 4, 0, 24);
    const int n_loc = CTXQ ? 0 : (clampi(r0 - 1, 0, 24) + 8 - R_lo);
    const int nb = n_loc + 4, nsteps = (nb + 1) >> 1;
    const int rp = wid >> 2, cb = wid & 3;
    const int qrow = r0 + 2 * rp + (l32 >> 4), qc = 16 * cb + (l32 & 15);
    const int a0 = clampi(16 * cb - 8, 0, 32);
    const int w_lo = clampi(r0 + 2 * rp - 4, 0, 24), w_hi = clampi(r0 + 2 * rp + 1 - 4, 0, 24) + 8;
    const int my_rs = clampi(qrow - 4, 0, 24), cs = clampi(qc - 8, 0, 48);
    const size_t qtok = CTXQ ? (size_t)(TLAT + b * CTXL + wid * 32 + l32) : (size_t)(b * SEQ + qrow * 64 + qc);
    if (!CTXQ) { if (tid < 465) ((LAS float*)(sm + OFF_BIAS))[tid] = rpb_lh[tid] * LOG2E; }
    bf16x8 qr[4];
#pragma unroll
    for (int kk = 0; kk < 4; ++kk) qr[kk] = *(const bf16x8*)(P1 + qtok * PW + h * HDIM + kk * 16 + hi * 8);
    const int skey = tid >> 3, sch = tid & 7;
    const int tq = (lane & 15) >> 2, tofs = 32 * ((lane >> 4) & 1) + 8 * (lane & 3);
    const unsigned kw_off = OFF_K + skey * KP + sch * 16, vw_off = OFF_V + skey * KP + sch * 16;
    const bf16* const sbase = P1 + (size_t)skey * PW + h * HDIM + sch * 8;
#define BLK_TOK(t) ((t) < n_loc ? (size_t)(b * SEQ + (R_lo + (t)) * 64) : (size_t)(TLAT + b * CTXL + ((t) - n_loc) * 64))
#define STAGE_LOAD(st) do { _Pragma("unroll") for (int s_ = 0; s_ < 2; ++s_) { const int t_ = 2 * (st) + s_; if (t_ < nb) { const bf16* src_ = sbase + BLK_TOK(t_) * PW; kreg[s_] = *(const v4u*)(src_ + AW); vreg[s_] = *(const v4u*)(src_ + 2 * AW); } } } while (0)
#define STAGE_WRITE(st, buf) do { _Pragma("unroll") for (int s_ = 0; s_ < 2; ++s_) { if (2 * (st) + s_ < nb) { *(LAS v4u*)(sm + kw_off + ((buf) * 2 + s_) * BLK_B) = kreg[s_]; *(LAS v4u*)(sm + vw_off + ((buf) * 2 + s_) * BLK_B) = vreg[s_]; } } } while (0)
#define VFRAG(dst, vb_, dh_, a_, s2_) do { const LAS unsigned char* vp_ = (vb_) + ((a_) + 16 * (s2_) + 4 * hi + tq) * KP + 64 * (dh_) + tofs; \
        const s16x4 lo_ = __builtin_bit_cast(s16x4, __builtin_amdgcn_ds_read_tr16_b64_v4i16((LAS s16x4*)vp_)), hi_ = __builtin_bit_cast(s16x4, __builtin_amdgcn_ds_read_tr16_b64_v4i16((LAS s16x4*)(vp_ + 8 * KP))); \
        dst = __builtin_shufflevector(lo_, hi_, 0, 1, 2, 3, 4, 5, 6, 7); } while (0)
#define PACK8(dst, x_, o_) do { v4u w_; w_.x = cvt_pk_bf16(x_[(o_) + 0], x_[(o_) + 1]); w_.y = cvt_pk_bf16(x_[(o_) + 2], x_[(o_) + 3]); w_.z = cvt_pk_bf16(x_[(o_) + 4], x_[(o_) + 5]); w_.w = cvt_pk_bf16(x_[(o_) + 6], x_[(o_) + 7]); dst = __builtin_bit_cast(bf16x8, w_); } while (0)
    v4u kreg[2], vreg[2];
    STAGE_LOAD(0); STAGE_WRITE(0, 0);
    __syncthreads();
    float m = -1e30f, lsum = 0.f; f32x16 o[2];
#pragma unroll
    for (int r = 0; r < 16; ++r) { o[0][r] = 0.f; o[1][r] = 0.f; }
    for (int st = 0; st < nsteps; ++st) {
        const int buf = st & 1;
        if (st + 1 < nsteps) STAGE_LOAD(st + 1);
#pragma unroll 1
        for (int s = 0; s < 2; ++s) {
            const int t = 2 * st + s; if (t >= nb) break;
            const LAS unsigned char* kb = sm + OFF_K + (buf * 2 + s) * BLK_B; const LAS unsigned char* vb = sm + OFF_V + (buf * 2 + s) * BLK_B;
            if (!CTXQ && t < n_loc) {
                const int keyrow = R_lo + t;
                if (keyrow < w_lo || keyrow >= w_hi) continue;
                f32x16 sp;
#pragma unroll
                for (int r = 0; r < 16; ++r) sp[r] = 0.f;
#pragma unroll
                for (int kk = 0; kk < 4; ++kk) { const bf16x8 a = *(const LAS bf16x8*)(kb + (a0 + l32) * KP + kk * 32 + hi * 16); sp = MFMA32(a, qr[kk], sp); }
                const LAS float* brow = (const LAS float*)(sm + OFF_BIAS) + ((keyrow - qrow + 7) * 31 + 15 + a0 + 4 * hi - qc);
                const int wofs = ((unsigned)(keyrow - my_rs) < 8u) ? (a0 + 4 * hi - cs) : 4096;
                float bv[16];
#pragma unroll
                for (int r = 0; r < 16; ++r) bv[r] = brow[(r & 3) + 8 * (r >> 2)];
                asm volatile("" : "+v"(bv[0]), "+v"(bv[1]), "+v"(bv[2]), "+v"(bv[3]), "+v"(bv[4]), "+v"(bv[5]), "+v"(bv[6]), "+v"(bv[7]), "+v"(bv[8]), "+v"(bv[9]), "+v"(bv[10]), "+v"(bv[11]), "+v"(bv[12]), "+v"(bv[13]), "+v"(bv[14]), "+v"(bv[15]));
#pragma unroll
                for (int r = 0; r < 16; ++r) { const bool inw = (unsigned)((r & 3) + 8 * (r >> 2) + wofs) < 16u; sp[r] = inw ? sp[r] + bv[r] : -3e38f; }
                float mx = sp[0];
#pragma unroll
                for (int r = 1; r < 16; ++r) mx = fmaxf(mx, sp[r]);
                mx = fmaxf(mx, __shfl_xor(mx, 32));
                const float mn = fmaxf(m, mx), alpha = __builtin_amdgcn_exp2f(m - mn); m = mn;
                float ps = 0.f;
#pragma unroll
                for (int r = 0; r < 16; ++r) { sp[r] = __builtin_amdgcn_exp2f(sp[r] - mn); ps += sp[r]; }
                lsum = lsum * alpha + ps;
#pragma unroll
                for (int r = 0; r < 16; ++r) { o[0][r] *= alpha; o[1][r] *= alpha; }
                bf16x8 pb[2]; PACK8(pb[0], sp, 0); PACK8(pb[1], sp, 8);
#pragma unroll
                for (int dh = 0; dh < 2; ++dh)
#pragma unroll
                    for (int s2 = 0; s2 < 2; ++s2) { bf16x8 a; VFRAG(a, vb, dh, a0, s2); o[dh] = MFMA32(a, pb[s2], o[dh]); }
            } else {
                f32x16 sp[2];
#pragma unroll
                for (int p = 0; p < 2; ++p) {
#pragma unroll
                    for (int r = 0; r < 16; ++r) sp[p][r] = 0.f;
#pragma unroll
                    for (int kk = 0; kk < 4; ++kk) { const bf16x8 a = *(const LAS bf16x8*)(kb + (32 * p + l32) * KP + kk * 32 + hi * 16); sp[p] = MFMA32(a, qr[kk], sp[p]); }
                }
                float mx = sp[0][0];
#pragma unroll
                for (int r = 1; r < 16; ++r) mx = fmaxf(mx, sp[0][r]);
#pragma unroll
                for (int r = 0; r < 16; ++r) mx = fmaxf(mx, sp[1][r]);
                mx = fmaxf(mx, __shfl_xor(mx, 32));
                const float mn = fmaxf(m, mx), alpha = __builtin_amdgcn_exp2f(m - mn); m = mn;
                float ps = 0.f;
#pragma unroll
                for (int p = 0; p < 2; ++p)
#pragma unroll
                    for (int r = 0; r < 16; ++r) { sp[p][r] = __builtin_amdgcn_exp2f(sp[p][r] - mn); ps += sp[p][r]; }
                lsum = lsum * alpha + ps;
#pragma unroll
                for (int r = 0; r < 16; ++r) { o[0][r] *= alpha; o[1][r] *= alpha; }
                bf16x8 pb[2][2]; PACK8(pb[0][0], sp[0], 0); PACK8(pb[0][1], sp[0], 8); PACK8(pb[1][0], sp[1], 0); PACK8(pb[1][1], sp[1], 8);
#pragma unroll
                for (int dh = 0; dh < 2; ++dh)
#pragma unroll
                    for (int p = 0; p < 2; ++p)
#pragma unroll
                        for (int s2 = 0; s2 < 2; ++s2) { bf16x8 a; VFRAG(a, vb, dh, 32 * p, s2); o[dh] = MFMA32(a, pb[p][s2], o[dh]); }
            }
        }
        if (st + 1 < nsteps) STAGE_WRITE(st + 1, buf ^ 1);
        __syncthreads();
    }
    const float ltot = lsum + __shfl_xor(lsum, 32), inv = 1.f / ltot;
    bf16* yrow = YA + qtok * AW + h * HDIM + 4 * hi;
#pragma unroll
    for (int dh = 0; dh < 2; ++dh)
#pragma unroll
        for (int g = 0; g < 4; ++g) { v2u w; w.x = cvt_pk_bf16(o[dh][4 * g] * inv, o[dh][4 * g + 1] * inv); w.y = cvt_pk_bf16(o[dh][4 * g + 2] * inv, o[dh][4 * g + 3] * inv);
            *(v2u*)(yrow + 32 * dh + 8 * g) = w; }
#undef BLK_TOK
#undef STAGE_LOAD
#undef STAGE_WRITE
#undef VFRAG
#undef PACK8
}
}

__device__ __forceinline__ void conv_phase(Frame& F, const bf16* P1, bf16* YC, const float* wconv  , int nrows) {
    const int gw = blockIdx.x * NWAVES + F.wave, NGW = F.G * NWAVES, ch0 = F.lane * 8;
    float w0[8], w1[8], w2[8];
#pragma unroll
    for (int i = 0; i < 8; ++i) { w0[i] = wconv[ch0 + i]; w1[i] = wconv[CW + ch0 + i]; w2[i] = wconv[2 * CW + ch0 + i]; }
    for (int ck = gw; ck < nrows / 8; ck += NGW) {
        const int t0 = ck * 8; const int seq = t0 < TLAT ? SEQ : CTXL;
        const bool has_prev = (t0 % seq) != 0, has_next = ((t0 + 8) % seq) != 0;
        v4u cgv[10], uv[10], bgv[8];
#pragma unroll
        for (int i = 0; i < 10; ++i) { const int row = t0 - 1 + i; const bool ok = (i > 0 || has_prev) && (i < 9 || has_next);
            if (ok) { cgv[i] = *(const v4u*)(P1 + (size_t)row * PW + 3 * AW + CW + ch0); uv[i] = *(const v4u*)(P1 + (size_t)row * PW + 3 * AW + 2 * CW + ch0); }
            else { cgv[i] = (v4u){0u, 0u, 0u, 0u}; uv[i] = (v4u){0u, 0u, 0u, 0u}; } }
#pragma unroll
        for (int i = 0; i < 8; ++i) bgv[i] = *(const v4u*)(P1 + (size_t)(t0 + i) * PW + 3 * AW + ch0);
        float zp[8], zc[8], zn[8];
#define MKZ(dst, a_, b_) do { dst[0] = bf_lo(a_.x) * bf_lo(b_.x); dst[1] = bf_hi(a_.x) * bf_hi(b_.x); dst[2] = bf_lo(a_.y) * bf_lo(b_.y); dst[3] = bf_hi(a_.y) * bf_hi(b_.y); \
        dst[4] = bf_lo(a_.z) * bf_lo(b_.z); dst[5] = bf_hi(a_.z) * bf_hi(b_.z); dst[6] = bf_lo(a_.w) * bf_lo(b_.w); dst[7] = bf_hi(a_.w) * bf_hi(b_.w); } while (0)
        MKZ(zp, cgv[0], uv[0]); MKZ(zc, cgv[1], uv[1]);
#pragma unroll
        for (int i8 = 0; i8 < 8; ++i8) {
            MKZ(zn, cgv[i8 + 2], uv[i8 + 2]);
            const v4u g_ = bgv[i8];
            const float bgf[8] = {bf_lo(g_.x), bf_hi(g_.x), bf_lo(g_.y), bf_hi(g_.y), bf_lo(g_.z), bf_hi(g_.z), bf_lo(g_.w), bf_hi(g_.w)};
            float y[8];
#pragma unroll
            for (int i = 0; i < 8; ++i) y[i] = bgf[i] * (w0[i] * zp[i] + w1[i] * zc[i] + w2[i] * zn[i]);
            v4u w; w.x = cvt_pk_bf16(y[0], y[1]); w.y = cvt_pk_bf16(y[2], y[3]); w.z = cvt_pk_bf16(y[4], y[5]); w.w = cvt_pk_bf16(y[6], y[7]);
            *(v4u*)(YC + (size_t)(t0 + i8) * CW + ch0) = w;
#pragma unroll
            for (int i = 0; i < 8; ++i) { zp[i] = zc[i]; zc[i] = zn[i]; }
        }
#undef MKZ
    }
}

__device__ __forceinline__ void router_phase(Frame& F, const float* gain, const float* modl, const float* w_router) {
    LAS float* wr = (LAS float*)(F.lds);
    LAS unsigned* lc = (LAS unsigned*)(F.lds + 32768);
    LAS unsigned* tk = (LAS unsigned*)(F.lds + 32768 + 64);
    for (int i = F.tid; i < 1024 * 8; i += NWAVES * 64) wr[i] = w_router[i];
    if (F.tid < 8) lc[F.tid] = 0u;
    __syncthreads();
    unsigned* R = (unsigned*)(F.ws + WS_ROUTE);
    RowVec g, sh, sc; row_load(g, gain, F.lane);
    int cur_b = -1;
    for (int base = blockIdx.x * 64; base < TLAT; base += F.G * 64) {
#pragma unroll 1
        for (int i = 0; i < 8; ++i) {
            const int ti = F.wave * 8 + i, row = base + ti, b = row / SEQ;
            if (b != cur_b) { row_load(sh, modl + (size_t)b * 6144 + 3 * D, F.lane); row_load(sc, modl + (size_t)b * 6144 + 4 * D, F.lane); cur_b = b; }
            RowVec x; row_load(x, (const float*)(F.ws + WS_X) + (size_t)row * D, F.lane);
            const float r = row_rms_scale(x);
            float lg[8];
#pragma unroll
            for (int e = 0; e < 8; ++e) lg[e] = 0.f;
#pragma unroll
            for (int j = 0; j < 4; ++j) { const f32x4 hv = x.v[j] * r * g.v[j] * (1.f + sc.v[j]) + sh.v[j]; x.v[j] = hv;
#pragma unroll
                for (int q = 0; q < 4; ++q) { const LAS f32x4* wq = (const LAS f32x4*)(wr + (256 * j + 4 * F.lane + q) * 8); const f32x4 wa = wq[0], wb = wq[1];
                    lg[0] += hv[q] * wa.x; lg[1] += hv[q] * wa.y; lg[2] += hv[q] * wa.z; lg[3] += hv[q] * wa.w; lg[4] += hv[q] * wb.x; lg[5] += hv[q] * wb.y; lg[6] += hv[q] * wb.z; lg[7] += hv[q] * wb.w; } }
            row_store_fp8(x, F.ws + WS_YE + (size_t)row * D, F.lane, S_H2);
#pragma unroll
            for (int e = 0; e < 8; ++e) lg[e] = wave_sum(lg[e]);
            int i1 = 0; float v1 = lg[0];
#pragma unroll
            for (int e = 1; e < 8; ++e) if (lg[e] > v1) { v1 = lg[e]; i1 = e; }
            int i2 = -1; float v2 = -3e38f;
#pragma unroll
            for (int e = 0; e < 8; ++e) if (e != i1 && lg[e] > v2) { v2 = lg[e]; i2 = e; }
            if (F.lane == 0) {
                const float e2 = __expf(v2 - v1), p1 = 1.f / (1.f + e2), p2 = e2 * p1;
                const unsigned lp1 = __hip_atomic_fetch_add(lc + i1, 1u, __ATOMIC_RELAXED, __HIP_MEMORY_SCOPE_WORKGROUP), lp2 = __hip_atomic_fetch_add(lc + i2, 1u, __ATOMIC_RELAXED, __HIP_MEMORY_SCOPE_WORKGROUP);
                tk[ti * 6 + 0] = (unsigned)i1; tk[ti * 6 + 1] = (unsigned)i2; tk[ti * 6 + 2] = lp1; tk[ti * 6 + 3] = lp2; tk[ti * 6 + 4] = __float_as_uint(p1); tk[ti * 6 + 5] = __float_as_uint(p2);
            }
        }
        __syncthreads();
        if (F.tid < 8) lc[8 + F.tid] = __hip_atomic_fetch_add(F.ctl + CW_FILL + 64 * F.tid, lc[F.tid], RLX_AGENT);
        __syncthreads();
        if (F.tid < 64) { const int row = base + F.tid; const unsigned e1 = tk[F.tid * 6], e2 = tk[F.tid * 6 + 1];
            R[row] = e1 | (e2 << 8); R[TLAT + row] = lc[8 + e1] + tk[F.tid * 6 + 2]; R[2 * TLAT + row] = lc[8 + e2] + tk[F.tid * 6 + 3]; R[3 * TLAT + row] = tk[F.tid * 6 + 4]; R[4 * TLAT + row] = tk[F.tid * 6 + 5]; }
        __syncthreads();
        if (F.tid < 8) lc[F.tid] = 0u;
        __syncthreads();
    }
}
__device__ __forceinline__ void moe_table(Frame& F, LAS int* tab) {
    if (F.tid == 0) { int acc = 0;
        for (int e = 0; e < 8; ++e) { tab[e] = acc; const unsigned c = __hip_atomic_load(F.ctl + CW_FILL + 64 * e, RLX_AGENT); acc += (int)((c + 255u) >> 8); }
        tab[8] = acc; }
    __syncthreads();
}
__device__ __forceinline__ void scatter_h2_phase(Frame& F, LAS int* tab) {
    const unsigned* R = (const unsigned*)(F.ws + WS_ROUTE);
    unsigned char* H2P = F.ws + WS_RA; const unsigned char* H2T = F.ws + WS_YE;
    const int gw = blockIdx.x * NWAVES + F.wave, NGW = F.G * NWAVES;
    for (int row0 = gw * 4; row0 < TLAT; row0 += NGW * 4) {
        v4u v[4]; size_t s1[4], s2[4];
#pragma unroll
        for (int i = 0; i < 4; ++i) { const int row = row0 + i; v[i] = *(const GAS v4u*)(H2T + (size_t)row * D + F.lane * 16);
            const unsigned ee = R[row]; const int e1 = ee & 255u, e2 = ee >> 8;
            s1[i] = (size_t)tab[e1] * 256 + R[TLAT + row]; s2[i] = (size_t)tab[e2] * 256 + R[2 * TLAT + row]; }
#pragma unroll
        for (int i = 0; i < 4; ++i) { *(GAS v4u*)(H2P + s1[i] * D + F.lane * 16) = v[i]; *(GAS v4u*)(H2P + s2[i] * D + F.lane * 16) = v[i]; }
    }
}
__device__ __forceinline__ void final_phase(Frame& F, const float* modl, const float* gfin, float* out, LAS int* tab) {
    const unsigned* R = (const unsigned*)(F.ws + WS_ROUTE);
    const bf16* YE = (const bf16*)(F.ws + WS_YE);
    const int gw = blockIdx.x * NWAVES + F.wave, NGW = F.G * NWAVES, per = (TLAT + NGW - 1) / NGW;
    RowVec g, g2; row_load(g, gfin, F.lane);
    int cur_b = -1;
    for (int i = 0; i < per; ++i) {
        const int row = gw * per + i; if (row >= TLAT) break;
        const int b = row / SEQ;
        if (b != cur_b) { row_load(g2, modl + (size_t)b * 6144 + 5 * D, F.lane); cur_b = b; }
        RowVec x; row_load(x, (const float*)(F.ws + WS_X) + (size_t)row * D, F.lane);
        const unsigned ee = R[row]; const int e1 = ee & 255u, e2 = ee >> 8;
        const size_t s1 = (size_t)tab[e1] * 256 + R[TLAT + row], s2 = (size_t)tab[e2] * 256 + R[2 * TLAT + row];
        const float p1 = __uint_as_float(R[3 * TLAT + row]), p2 = __uint_as_float(R[4 * TLAT + row]);
        const GAS v2u* y1 = (const GAS v2u*)(YE + s1 * D) + F.lane; const GAS v2u* y2 = (const GAS v2u*)(YE + s2 * D) + F.lane;
#pragma unroll
        for (int j = 0; j < 4; ++j) { const v2u a = y1[64 * j], c = y2[64 * j];
            f32x4 y; y.x = p1 * bf_lo(a.x) + p2 * bf_lo(c.x); y.y = p1 * bf_hi(a.x) + p2 * bf_hi(c.x); y.z = p1 * bf_lo(a.y) + p2 * bf_lo(c.y); y.w = p1 * bf_hi(a.y) + p2 * bf_hi(c.y);
            x.v[j] = x.v[j] + g2.v[j] * y; }
        const float r = row_rms_scale(x);
        GAS f32x4* o = (GAS f32x4*)(out + (size_t)row * D) + F.lane;
#pragma unroll
        for (int j = 0; j < 4; ++j) o[64 * j] = x.v[j] * r * g.v[j];
    }
}


#ifndef REPEAT_MASK
#define REPEAT_MASK 0u
#endif
#ifndef REPEAT_EXTRA
#define REPEAT_EXTRA 2
#endif
#ifndef PH_MASK
#define PH_MASK 0xFFFFFu
#endif
#define PH_ON(k) (((PH_MASK) >> (k)) & 1u)
#define IN(k) (lo <= (k) && (k) < hi)
#define BOTH(k) (IN(k) && IN((k) + 1))
#define GRID_BAR() do { if (N_LAUNCHES == 1) xcd_barrier(bar); } while (0)
template <int L>
__device__ __forceinline__ void mixer_layer(Frame& F, const XcdBarrier& bar, int lo, int hi) {
    constexpr int pb = 1 + 9 * L;
    constexpr int mrows = (L == 0) ? TALL : TLAT;
    if (PH_ON(pb) && IN(pb)) { modulate_phase(F, L == 0, F.in[6] + L * D, (const float*)(F.ws + WS_MOD) + (size_t)L * 9 * 6144, 0, D, (bf16*)(F.ws + WS_RA), TALL, F.ws + WS_H8, mrows); if (BOTH(pb)) GRID_BAR(); }
    if (PH_ON(pb + 1) && IN(pb + 1)) {
        const unsigned char* wm = F.ws + (L == 0 ? WS_WM0 : WS_WM1);
        constexpr int nwg1 = (L == 0) ? (TALL / 256) * 12 : 64 * 12 + 32;
        { pg8::Gemm g{(const bf16*)(F.ws + WS_RA), (const bf16*)(wm + WM_G1), TALL, 3072, 1024, (size_t)3072 * 128};
          pg8::EpiProj E{(bf16*)(F.ws + WS_RB), 0.125f * LOG2E};
          if (L == 0) { pg8::StaticOrder S; S.init(TALL, 3072, F.G, (int)blockIdx.x); pg8::gemm_phase<pg8::EpiProj, pg8::StaticOrder, PG8_ALIGN, PG8_SP2>(F.lds + RING_OFF, g, S, E); }
          else { pg8::ProjL1Order S; S.init(F.G, (int)blockIdx.x); pg8::gemm_phase<pg8::EpiProj, pg8::ProjL1Order, PG8_ALIGN, PG8_SP2>(F.lds + RING_OFF, g, S, E); } }
        { const int c2 = (int)((blockIdx.x + F.G - (unsigned)(nwg1 % F.G)) % F.G);
          pg8::Gemm g{(const bf16*)(F.ws + WS_H8), (const bf16*)(wm + WM_G8), mrows, 2048, 512, (size_t)2048 * 128};
          pg8::EpiGate E{(bf16*)(F.ws + WS_GT), F.in[14] + L * GW, 1.f / (S_H2 * S_W)};
          pg8::StaticOrder S; S.init(mrows, 2048, F.G, c2); pg8::gemm_phase<pg8::EpiGate, pg8::StaticOrder, PG8_ALIGN, PG8_SP2, true>(F.lds + RING_OFF, g, S, E);
          constexpr int nwg2 = (mrows / 256) * 8;
          const int r12 = nwg1 % F.G + nwg2 % F.G; const bool some = r12 < F.G;
          const bool part = !some || (int)blockIdx.x >= r12; const int p = some ? (int)blockIdx.x - r12 : (int)blockIdx.x, n_part = some ? F.G - r12 : F.G;
          if (L == 0) filler_part(F, part, p, n_part, DW_PB0, DW_PD0A); else filler_part(F, part, p, n_part, DW_PB1, DW_END); }
        if (BOTH(pb + 1)) GRID_BAR();
    }
    if (PH_ON(pb + 2) && IN(pb + 2)) {
        const bf16* P1 = (const bf16*)(F.ws + WS_RB); bf16* YA = (bf16*)(F.ws + WS_RA); bf16* YC = (bf16*)(F.ws + WS_RA + (size_t)TALL * AW * 2);
        const float* rpb = F.in[10] + (size_t)L * NHEAD * 465;
#ifndef ATT_REPS
#define ATT_REPS 1
#endif
#ifndef CONV_REPS
#define CONV_REPS 1
#endif
        for (int rep = 0; rep < ATT_REPS; ++rep) {
        for (int u = blockIdx.x; u < 512; u += F.G) { const int b = u >> 6, h = (u >> 3) & 7, r0 = (u & 7) * 4; att::attn_unit<false>(F.lds + RING_OFF, P1, YA, rpb + h * 465, b, h, r0); }
        if (L == 0) for (int v = (int)blockIdx.x - (F.G - 64); v >= 0 && v < 64; v += F.G) att::attn_unit<true>(F.lds + RING_OFF, P1, YA, rpb, v >> 3, v & 7, 0);
        }
        for (int rep = 0; rep < CONV_REPS; ++rep) conv_phase(F, P1, YC, F.in[9] + (size_t)L * 3 * CW, mrows);
        if (BOTH(pb + 2)) GRID_BAR();
    }
    if (PH_ON(pb + 3) && IN(pb + 3)) {
        const unsigned char* wm = F.ws + (L == 0 ? WS_WM0 : WS_WM1);
        bf16* MG = (bf16*)(F.ws + WS_RB); const bf16* GT = (const bf16*)(F.ws + WS_GT);
        pg8::StaticOrder S; S.init(mrows, 1024, F.G, (int)blockIdx.x);
        { pg8::Gemm g{(const bf16*)(F.ws + WS_RA), (const bf16*)(wm + WM_A), mrows, 1024, 512, (size_t)1024 * 128}; pg8::EpiMerge<false> E{MG, GT, 0};
          pg8::gemm_phase<pg8::EpiMerge<false>, pg8::StaticOrder, PG8_ALIGN, PG8_SP2>(F.lds + RING_OFF, g, S, E); if (L == 0) filler(F, TALL / 256 * 4, DW_PD0A, DW_PD0B); }
        { pg8::Gemm g{(const bf16*)(F.ws + WS_RA + (size_t)TALL * AW * 2), (const bf16*)(wm + WM_C), mrows, 1024, 512, (size_t)1024 * 128}; pg8::EpiMerge<true> E{MG, GT, 1024};
          pg8::gemm_phase<pg8::EpiMerge<true>, pg8::StaticOrder, PG8_ALIGN, PG8_SP2>(F.lds + RING_OFF, g, S, E); if (L == 0) filler(F, TALL / 256 * 4, DW_PD0B, DW_PE0); }
        if (BOTH(pb + 3)) GRID_BAR();
    }
    if (PH_ON(pb + 4) && IN(pb + 4)) {
        float* X = (float*)(F.ws + WS_X);
        pg8::StaticOrder S; S.init(mrows, 1024, F.G, (int)blockIdx.x);
        pg8::Gemm g{(const bf16*)(F.ws + WS_RB), (const bf16*)(F.ws + (L == 0 ? WS_WM0 : WS_WM1) + WM_O), mrows, 1024, 1024, (size_t)1024 * 128};
        pg8::EpiResid E{L == 0 ? F.in[0] : X, L == 0 ? F.in[2] : X + (size_t)TLAT * D, X, (const float*)(F.ws + WS_MOD) + (size_t)L * 9 * 6144 + 2 * D};
        pg8::gemm_phase<pg8::EpiResid, pg8::StaticOrder, PG8_ALIGN, PG8_SP2>(F.lds + RING_OFF, g, S, E);
        if (L == 0) filler(F, TALL / 256 * 4, DW_PE0, DW_PG0);
        if (BOTH(pb + 4)) GRID_BAR();
    }
}
struct Args { const float* in[24]; float* out; unsigned char* ws; int ph_lo, ph_hi; };
__global__ void __launch_bounds__(NWAVES * 64, 2) fwd(Args args) {
    extern __shared__ __attribute__((aligned(16))) unsigned char lds[];
    Frame F;
    F.lds = (LAS unsigned char*)lds;
    F.MISC = (volatile LAS unsigned*)(F.lds + MISC_OFF);
    F.tid = threadIdx.x; F.lane = F.tid & 63; F.wave = __builtin_amdgcn_readfirstlane(F.tid >> 6);
    F.G = gridDim.x; F.ws = args.ws; F.ctl = (unsigned*)(args.ws + WS_CTL); F.in = args.in;
    for (int u = F.tid; u < (LDS_BYTES - LDSCTL_OFF) / 4; u += NWAVES * 64) ((LAS unsigned*)(F.lds + LDSCTL_OFF))[u] = 0u;
    __syncthreads();
    XcdBarrier bar; bar.bar = F.ctl + CW_BAR; bar.x = 0; bar.st = nullptr;
    if (N_LAUNCHES == 1) bar = xcd_barrier_post(F.ctl + CW_BAR, F.MISC + 8);
    const int lo = args.ph_lo, hi = args.ph_hi;
    float* X = (float*)(F.ws + WS_X);
    const float* MOD = (const float*)(F.ws + WS_MOD);
    LAS int* tab = (LAS int*)(F.lds + LDSCTL_OFF + 64);

    if (PH_ON(0) && IN(0)) { p0_prologue(F); if (BOTH(0)) GRID_BAR(); }
    mixer_layer<0>(F, bar, lo, hi);
    if (PH_ON(6) || PH_ON(7) || PH_ON(8)) {
        const float* modl = MOD; bf16* H2 = (bf16*)(F.ws + WS_RA); bf16* HID = (bf16*)(F.ws + WS_RB);
        if (PH_ON(6) && IN(6)) { modulate_phase(F, false, F.in[7], modl, 3 * D, 4 * D, H2, TALL); if (BOTH(6)) GRID_BAR(); }
        if (PH_ON(7) && IN(7)) {
            pg8::StaticOrder S; S.init(TALL, 5632, F.G, (int)blockIdx.x);
            pg8::Gemm g{H2, (const bf16*)(F.ws + WS_WD + WD_GU), TALL, 5632, 1024, (size_t)5632 * 128}; pg8::EpiSwiGLU E{HID};
            pg8::gemm_phase<pg8::EpiSwiGLU, pg8::StaticOrder, PG8_ALIGN, PG8_SP2>(F.lds + RING_OFF, g, S, E);
            filler(F, TALL / 256 * 22, DW_PG0, DW_PH0);
            if (BOTH(7)) GRID_BAR();
        }
        if (PH_ON(8) && IN(8)) {
            pg8::StaticOrder S; S.init(TALL, 1024, F.G, (int)blockIdx.x);
            pg8::Gemm g{HID, (const bf16*)(F.ws + WS_WD + WD_DN), TALL, 1024, 2816, (size_t)1024 * 128};
            pg8::EpiResid E{X, X + (size_t)TLAT * D, X, modl + 5 * D};
            pg8::gemm_phase<pg8::EpiResid, pg8::StaticOrder, PG8_ALIGN, PG8_SP2>(F.lds + RING_OFF, g, S, E);
#ifndef EXP_PH0_IN_P0
            filler(F, TALL / 256 * 4, DW_PH0, DW_PB1);
#endif
            if (BOTH(8)) GRID_BAR();
        }
    }
    mixer_layer<1>(F, bar, lo, hi);
    {
        const float* modl = MOD + (size_t)9 * 6144;
        if (PH_ON(15) && IN(15)) { router_phase(F, F.in[7] + D, modl, F.in[19]); if (BOTH(15)) GRID_BAR(); }
        if (PH_ON(16) && IN(16)) { moe_table(F, tab); scatter_h2_phase(F, tab); if (BOTH(16)) GRID_BAR(); }
        if (PH_ON(17) && IN(17)) {
            moe_table(F, tab);
            pg8::MoEOrder S{tab, 22, F.G, (int)((blockIdx.x & 7) * (F.G >> 3) + (blockIdx.x >> 3))};
            pg8::Gemm g{(const bf16*)(F.ws + WS_RA), (const bf16*)(F.ws + WS_WE), SLOTS_MAX, 8 * 5632, 512, (size_t)NEXP * 5632 * 128}; pg8::EpiSwiGLU8 E{F.ws + WS_RB, 1.f / (S_H2 * S_W), S_HID};
            pg8::gemm_phase<pg8::EpiSwiGLU8, pg8::MoEOrder, PG8_ALIGN, PG8_SP2, true>(F.lds + RING_OFF, g, S, E);
            if (BOTH(17)) GRID_BAR();
        }
        if (PH_ON(18) && IN(18)) {
            moe_table(F, tab);
            pg8::MoEOrder S{tab, 4, F.G, (int)((blockIdx.x & 7) * (F.G >> 3) + (blockIdx.x >> 3))};
            pg8::Gemm g{(const bf16*)(F.ws + WS_RB), (const bf16*)(F.ws + WS_WED), SLOTS_MAX, 8 * 1024, 1408, (size_t)NEXP * 1024 * 128}; pg8::EpiYE E{(bf16*)(F.ws + WS_YE), 1.f / (S_HID * S_W)};
            pg8::gemm_phase<pg8::EpiYE, pg8::MoEOrder, PG8_ALIGN, PG8_SP2, true>(F.lds + RING_OFF, g, S, E);
            if (BOTH(18)) GRID_BAR();
        }
        if (PH_ON(19) && IN(19)) { moe_table(F, tab); final_phase(F, modl, F.in[23], args.out, tab); }
    }
#undef IN
#undef BOTH
#undef GRID_BAR
}

extern "C" void kernel_launch(void* const* d_in, const int* in_sizes, int n_in, void* d_out, int out_size, void* d_ws, size_t ws_size, hipStream_t stream) {
    static int grid = 0;
    if (grid == 0) {
        if (n_in != 24 || out_size != TLAT * D || ws_size < WS_END) { fprintf(stderr, "kernel_launch: unexpected shapes / workspace (%d inputs, out %d, ws %zu); nothing launched\n", n_in, out_size, ws_size); grid = -1; return; }
        int dev = 0, cus = 0, per_cu = 0;
        if (hipGetDevice(&dev) != hipSuccess || hipDeviceGetAttribute(&cus, hipDeviceAttributeMultiprocessorCount, dev) != hipSuccess) { grid = -1; return; }
        if (hipFuncSetAttribute((const void*)fwd, hipFuncAttributeMaxDynamicSharedMemorySize, LDS_BYTES) != hipSuccess) { fprintf(stderr, "kernel_launch: hipFuncSetAttribute failed\n"); grid = -1; return; }
        if (hipOccupancyMaxActiveBlocksPerMultiprocessor(&per_cu, (const void*)fwd, NWAVES * 64, LDS_BYTES) != hipSuccess || per_cu < 1) fprintf(stderr, "kernel_launch: occupancy query reports %d\n", per_cu);
        (void)hipGetLastError();
        grid = cus;
    }
    if (grid < 0) return;
    if (hipMemsetAsync((char*)d_ws + WS_CTL, 0, CTL_ZERO_BYTES, stream) != hipSuccess) return;
    Args a{};
    for (int i = 0; i < 24; ++i) a.in[i] = (const float*)d_in[i];
    a.out = (float*)d_out; a.ws = (unsigned char*)d_ws;
    if (N_LAUNCHES == 1) { a.ph_lo = 0; a.ph_hi = NPHASE + 1; hipLaunchKernelGGL(fwd, dim3(grid), dim3(NWAVES * 64), LDS_BYTES, stream, a); }
    else for (int p = 0; p <= NPHASE; ++p) { if (p == 9) continue; a.ph_lo = p; a.ph_hi = p + 1;
        const int reps = 1 + ((((unsigned)(REPEAT_MASK)) >> p) & 1u) * REPEAT_EXTRA;
        for (int r = 0; r < reps; ++r) hipLaunchKernelGGL(fwd, dim3(grid), dim3(NWAVES * 64), LDS_BYTES, stream, a); }
}
```
